# Optimizing an MI355X kernel written in HIP

```python
import math
import jax, jax.numpy as jnp
from jax import lax
import numpy as np

D_MODEL = 1024
BATCH = 8
SEQ = 8192
DEPTH = 4

GRID_W = 64
D_FF = 2816
N_AB = (DEPTH + 1) // 2
N_C = DEPTH // 2
D_POOL = D_MODEL // 2
POOL_WINDOWS = (2, 4, 8, 16)
N_POOL_GROUPS = len(POOL_WINDOWS)
POOL_GROUP = D_POOL // N_POOL_GROUPS
D_SSM = D_MODEL - D_POOL
SSM_GROUP = 16
N_SSM_GROUPS = D_SSM // SSM_GROUP
SSM_STATE = 64
N_HEADS = 16
HEAD_DIM = D_MODEL // N_HEADS
D_ATTN = N_HEADS * HEAD_DIM
MAX_KH = 8
KW = 16
RMS_EPS = 1e-6
DT_MIN = 1e-3
DT_MAX = 1e-1
A_RE_MAX = -1e-4

kernel_name = 'hybrid_pool_s5_natten_macaron'

F32 = jnp.float32


def rms_norm(x, g):
    xf = x.astype(F32)
    y = xf * lax.rsqrt(jnp.mean(xf * xf, axis=-1, keepdims=True) + RMS_EPS)
    return (y * g.astype(F32)).astype(x.dtype)


def swiglu_ffn(x, w_gate, w_up, w_down):
    return (jax.nn.silu(x @ w_gate) * (x @ w_up)) @ w_down


def pool_mixer(u, w_grp, scale):
    bsz, L, _ = u.shape
    uf = u.astype(F32)
    cs = jnp.concatenate([jnp.zeros((bsz, 1, D_POOL), F32), jnp.cumsum(uf, axis=1)], axis=1)
    t = jnp.arange(L)
    outs = []
    for gi, w in enumerate(POOL_WINDOWS):
        lo = w // 2
        hi = w - 1 - lo
        start = jnp.clip(t - lo, 0, L)
        end = jnp.clip(t + hi + 1, 0, L)
        c0, c1 = gi * POOL_GROUP, (gi + 1) * POOL_GROUP
        csg = cs[:, :, c0:c1]
        cnt = (end - start).astype(F32)[None, :, None]
        outs.append((csg[:, end] - csg[:, start]) / cnt - uf[:, :, c0:c1])
    p = jnp.stack(outs, axis=2)
    y = jnp.einsum('blgc,gcd->blgd', p, w_grp.astype(F32)).reshape(bsz, L, D_POOL)
    return (y * scale.astype(F32)).astype(u.dtype)


def ssm_scan_dir(u, a_re, a_im, log_dt, b_re, b_im, c_re, c_im):
    L = u.shape[0]
    a_re = jnp.minimum(a_re.astype(F32), A_RE_MAX)
    a_im = a_im.astype(F32)
    dt = jnp.exp(log_dt.astype(F32))[:, None]
    mag = jnp.exp(a_re * dt)
    lam_re = mag * jnp.cos(a_im * dt)
    lam_im = mag * jnp.sin(a_im * dt)
    num_re = lam_re - 1.0
    num_im = lam_im
    den = a_re * a_re + a_im * a_im
    f_re = ((num_re * a_re + num_im * a_im) / den)[..., None]
    f_im = ((num_im * a_re - num_re * a_im) / den)[..., None]
    b_re = b_re.astype(F32)
    b_im = b_im.astype(F32)
    bb_re = f_re * b_re - f_im * b_im
    bb_im = f_re * b_im + f_im * b_re
    x_re = jnp.einsum('lbgh,gph->lbgp', u, bb_re)
    x_im = jnp.einsum('lbgh,gph->lbgp', u, bb_im)
    shp = (L, 1) + lam_re.shape
    l_re = jnp.broadcast_to(lam_re[None, None], shp)
    l_im = jnp.broadcast_to(lam_im[None, None], shp)

    def combine(e1, e2):
        a1r, a1i, b1r, b1i = e1
        a2r, a2i, b2r, b2i = e2
        return (a2r * a1r - a2i * a1i,
                a2r * a1i + a2i * a1r,
                a2r * b1r - a2i * b1i + b2r,
                a2r * b1i + a2i * b1r + b2i)

    _, _, s_re, s_im = lax.associative_scan(combine, (l_re, l_im, x_re, x_im), axis=0)
    return (jnp.einsum('lbgp,ghp->lbgh', s_re, c_re.astype(F32))
            - jnp.einsum('lbgp,ghp->lbgh', s_im, c_im.astype(F32)))


def s5_mixer(u, a_re, a_im, log_dt, b_re, b_im, c_re, c_im, d_skip, w_glu, b_glu):
    bsz, L, _ = u.shape
    uf = u.astype(F32)
    ug = jnp.transpose(uf.reshape(bsz, L, N_SSM_GROUPS, SSM_GROUP), (1, 0, 2, 3))
    y_f = ssm_scan_dir(ug, a_re[0], a_im[0], log_dt[0], b_re[0], b_im[0], c_re[0], c_im[0])
    y_b = jnp.flip(ssm_scan_dir(jnp.flip(ug, axis=0), a_re[1], a_im[1], log_dt[1],
                                b_re[1], b_im[1], c_re[1], c_im[1]), axis=0)
    y = jnp.transpose(y_f + y_b, (1, 0, 2, 3)).reshape(bsz, L, D_SSM) + d_skip.astype(F32) * uf
    y = jax.nn.gelu(y)
    y = y * jax.nn.sigmoid(y @ w_glu.astype(F32) + b_glu.astype(F32))
    return y.astype(u.dtype)


def neighborhood_attention(h, w_qkv, rpb, w_out):
    bsz, L, _ = h.shape
    rows = L // GRID_W
    kh = min(MAX_KH, rows)
    qkv = (h @ w_qkv).reshape(bsz, rows, GRID_W, 3, N_HEADS, HEAD_DIM)
    q = qkv[:, :, :, 0] * (HEAD_DIM ** -0.5)
    k = qkv[:, :, :, 1]
    v = qkv[:, :, :, 2]
    col = jnp.arange(GRID_W)
    col_start = jnp.clip(col - KW // 2, 0, GRID_W - KW)
    col_idx = col_start[:, None] + jnp.arange(KW)[None, :]
    col_bias_idx = col_idx - col[:, None] + (KW - 1)
    rpb_c = rpb.astype(F32)[:, :, col_bias_idx]

    def row_step(r):
        r0 = jnp.clip(r - kh // 2, 0, rows - kh)
        q_r = lax.dynamic_index_in_dim(q, r, axis=1, keepdims=False)
        k_band = lax.dynamic_slice_in_dim(k, r0, kh, axis=1)
        v_band = lax.dynamic_slice_in_dim(v, r0, kh, axis=1)
        k_nb = k_band[:, :, col_idx]
        v_nb = v_band[:, :, col_idx]
        row_bias_idx = r0 + jnp.arange(kh) - r + (MAX_KH - 1)
        bias = jnp.transpose(jnp.take(rpb_c, row_bias_idx, axis=1), (0, 2, 1, 3))
        s = jnp.einsum('bqhd,biqjhd->bhqij', q_r, k_nb).astype(F32) + bias[None]
        p = jax.nn.softmax(s.reshape(bsz, N_HEADS, GRID_W, kh * KW), axis=-1)
        p = p.reshape(bsz, N_HEADS, GRID_W, kh, KW).astype(v.dtype)
        return jnp.einsum('bhqij,biqjhd->bqhd', p, v_nb)

    o = lax.map(row_step, jnp.arange(rows))
    o = jnp.transpose(o, (1, 0, 2, 3, 4)).reshape(bsz, L, D_ATTN)
    return o @ w_out


def setup_inputs(seed: int = 0) -> dict:
    key = jax.random.key(seed)
    ks = jax.random.split(key, 24)
    nrm = jax.random.normal
    G, P, H = N_SSM_GROUPS, SSM_STATE, SSM_GROUP
    x = nrm(ks[0], (BATCH, SEQ, D_MODEL), F32)
    norm_g = 1.0 + 0.02 * nrm(ks[1], (DEPTH, 6, D_MODEL), F32)
    ffn_w_gate = nrm(ks[2], (DEPTH, 2, D_MODEL, D_FF), F32) * D_MODEL ** -0.5
    ffn_w_up = nrm(ks[3], (DEPTH, 2, D_MODEL, D_FF), F32) * D_MODEL ** -0.5
    ffn_w_down = nrm(ks[4], (DEPTH, 2, D_FF, D_MODEL), F32) * D_FF ** -0.5
    ab_w_in = nrm(ks[5], (N_AB, D_MODEL, D_POOL + D_SSM), F32) * D_MODEL ** -0.5
    pool_w = nrm(ks[6], (N_AB, N_POOL_GROUPS, POOL_GROUP, POOL_GROUP), F32) * POOL_GROUP ** -0.5
    pool_scale = 1.0 + 0.02 * nrm(ks[7], (N_AB, D_POOL), F32)
    n_idx = jnp.arange(P, dtype=F32)
    ssm_A_re = -0.5 + 0.01 * nrm(ks[8], (N_AB, 2, G, P), F32)
    ssm_A_im = math.pi * n_idx + 0.01 * nrm(ks[9], (N_AB, 2, G, P), F32)
    ssm_log_dt = jax.random.uniform(ks[10], (N_AB, 2, G), F32, math.log(DT_MIN), math.log(DT_MAX))
    ssm_B_re = nrm(ks[11], (N_AB, 2, G, P, H), F32) * (2.0 * H) ** -0.5
    ssm_B_im = nrm(ks[12], (N_AB, 2, G, P, H), F32) * (2.0 * H) ** -0.5
    ssm_C_re = nrm(ks[13], (N_AB, 2, G, H, P), F32) * (2.0 * P) ** -0.5
    ssm_C_im = nrm(ks[14], (N_AB, 2, G, H, P), F32) * (2.0 * P) ** -0.5
    ssm_D = nrm(ks[15], (N_AB, D_SSM), F32)
    ssm_w_glu = nrm(ks[16], (N_AB, D_SSM, D_SSM), F32) * D_SSM ** -0.5
    ssm_b_glu = 0.01 * nrm(ks[17], (N_AB, D_SSM), F32)
    ab_w_out = nrm(ks[18], (N_AB, D_POOL + D_SSM, D_MODEL), F32) * (D_POOL + D_SSM) ** -0.5
    na_w_qkv = nrm(ks[19], (N_C, D_MODEL, 3 * D_ATTN), F32) * D_MODEL ** -0.5
    na_rpb = 0.02 * nrm(ks[20], (N_C, N_HEADS, 2 * MAX_KH - 1, 2 * KW - 1), F32)
    na_w_out = nrm(ks[21], (N_C, D_ATTN, D_MODEL), F32) * D_ATTN ** -0.5
    return {'x': x, 'norm_g': norm_g, 'ffn_w_gate': ffn_w_gate, 'ffn_w_up': ffn_w_up,
            'ffn_w_down': ffn_w_down, 'ab_w_in': ab_w_in, 'pool_w': pool_w,
            'pool_scale': pool_scale, 'ssm_A_re': ssm_A_re, 'ssm_A_im': ssm_A_im,
            'ssm_log_dt': ssm_log_dt, 'ssm_B_re': ssm_B_re, 'ssm_B_im': ssm_B_im,
            'ssm_C_re': ssm_C_re, 'ssm_C_im': ssm_C_im, 'ssm_D': ssm_D,
            'ssm_w_glu': ssm_w_glu, 'ssm_b_glu': ssm_b_glu, 'ab_w_out': ab_w_out,
            'na_w_qkv': na_w_qkv, 'na_rpb': na_rpb, 'na_w_out': na_w_out}


def reference(x, norm_g, ffn_w_gate, ffn_w_up, ffn_w_down, ab_w_in, pool_w, pool_scale,
              ssm_A_re, ssm_A_im, ssm_log_dt, ssm_B_re, ssm_B_im, ssm_C_re, ssm_C_im,
              ssm_D, ssm_w_glu, ssm_b_glu, ab_w_out, na_w_qkv, na_rpb, na_w_out):
    h = x
    for layer in range(DEPTH):
        g = norm_g[layer]
        f = swiglu_ffn(rms_norm(h, g[0]), ffn_w_gate[layer, 0], ffn_w_up[layer, 0], ffn_w_down[layer, 0])
        h = h + 0.5 * rms_norm(f, g[1])
        hn = rms_norm(h, g[2])
        i = layer // 2
        if layer % 2 == 0:
            z = hn @ ab_w_in[i]
            ya = pool_mixer(z[..., :D_POOL], pool_w[i], pool_scale[i])
            yb = s5_mixer(z[..., D_POOL:], ssm_A_re[i], ssm_A_im[i], ssm_log_dt[i],
                          ssm_B_re[i], ssm_B_im[i], ssm_C_re[i], ssm_C_im[i],
                          ssm_D[i], ssm_w_glu[i], ssm_b_glu[i])
            m = jnp.concatenate([ya, yb], axis=-1) @ ab_w_out[i]
        else:
            m = neighborhood_attention(hn, na_w_qkv[i], na_rpb[i], na_w_out[i])
        h = h + rms_norm(m, g[3])
        f = swiglu_ffn(rms_norm(h, g[4]), ffn_w_gate[layer, 1], ffn_w_up[layer, 1], ffn_w_down[layer, 1])
        h = h + 0.5 * rms_norm(f, g[5])
    return h
```

```cpp
#include <hip/hip_runtime.h>
#include <hip/hip_cooperative_groups.h>
#include <cstdio>
#include <cstdint>
namespace cg = cooperative_groups;
namespace pg8 {
#define PG8_LAS __attribute__((address_space(3)))
typedef unsigned short bf16_t;
typedef short bf16x8 __attribute__((ext_vector_type(8)));
typedef float f32x4 __attribute__((ext_vector_type(4)));
typedef unsigned u32x4 __attribute__((ext_vector_type(4)));
constexpr int BM = 256, BK = 64, HALF = 128, HTB = HALF * BK * 2  , STAGE_BYTES = 8 * HTB, NXCD = 8, WGM = 8;

__host__ __device__ __forceinline__ int lds_byte(int r, int c) { const int st = (r >> 4) * 2 + (c >> 5), rr = r & 15, cc = c & 31, ob = rr * 64 + cc * 2; return st * 1024 + (ob ^ (((ob >> 9) & 1) << 5)); }
__host__ __device__ __forceinline__ void stage_rc(int b, int& R, int& C) { const int st = b / 1024, sb = b % 1024, swz = sb ^ (((sb >> 9) & 1) << 5); R = (st >> 1) * 16 + swz / 64; C = (st & 1) * 32 + (swz % 64) / 2; }
__host__ __device__ __forceinline__ int perm32(int rho) { const int n = rho >> 4, i = rho & 15; return 8 * (i >> 2) + 4 * n + (i & 3); }

struct Unit { int pm, pn, pb; };
struct Gemm { const bf16_t* A; const bf16_t* Bt; int M, N, K, lda, ldb; size_t sA, sB; };

struct StaticOrder {
    int nM, nN, nwg, G, c;
    __host__ __device__ void init(int M, int N, int G_, int c_) { nM = M / BM; nN = N / BM; nwg = nM * nN; G = G_; c = c_; }
    __host__ __device__ bool next(int i, Unit& u) const {
        const long L = (long)i * G + c; if (L >= nwg) return false;
        int wgid = (int)L; { const int q = nwg / NXCD, r = nwg % NXCD, xcd = wgid % NXCD, off = wgid / NXCD; wgid = (xcd < r ? xcd * (q + 1) : r * (q + 1) + (xcd - r) * q) + off; }
        const int nig = WGM * nN, gid = wgid / nig, fm = gid * WGM, gsz = (nM - fm) < WGM ? (nM - fm) : WGM;
        u.pm = fm + ((wgid % nig) % gsz); u.pn = (wgid % nig) / gsz; u.pb = 0; return true;
    }
    __device__ __forceinline__ void a_ready(const Unit&) const {}
    __device__ __forceinline__ void done(const Unit&) const {}
};


template <class Epi, class Sched, bool ALIGN_EPI = false, bool SP2 = false>
__device__ __forceinline__ void gemm_phase(PG8_LAS unsigned char* lds, const Gemm g, const Sched& S, const Epi& E) {
    int tid_ = threadIdx.x; asm volatile("" : "+v"(tid_));
    const int tid = tid_, wid = __builtin_amdgcn_readfirstlane(tid >> 6), lane = tid & 63, wr = wid >> 2, wc = wid & 3, fr = lane & 15, fq = lane >> 4;
    const int K = g.K, nt = K / BK;
    unsigned voffA[2], voffB[2];
#pragma unroll
    for (int i = 0; i < 2; ++i) { int R, C; stage_rc(tid * 16 + i * 8192, R, C); const int Rb = Epi::PERM ? ((R & ~31) + perm32(R & 31)) : R;
        voffA[i] = (unsigned)(R * g.lda + C) * 2u; voffB[i] = (unsigned)(Rb * g.ldb + C) * 2u; }
    const size_t kstep = (size_t)(BK * 2);
    const size_t hstepA = (size_t)HALF * g.lda * 2, hstepB = (size_t)HALF * g.ldb * 2;
    const size_t tstepA = 2 * hstepA, tstepB = 2 * hstepB;
    const unsigned ldsw = (unsigned)wid * 1024u;
    const int aoff = lds_byte(wr * 64 + fr, fq * 8), boff = lds_byte(wc * 32 + fr, fq * 8);
#define PG8_SA(b, h) (((b) * 2 + (h)) * HTB)
#define PG8_SB(b, h) ((4 + (b) * 2 + (h)) * HTB)
#define PG8_STAGE(bufoff, gbase, voff) do { _Pragma("unroll") for (int _i = 0; _i < 2; ++_i) \
        __builtin_amdgcn_global_load_lds((const unsigned*)((const char*)(gbase) + (voff)[_i]), (PG8_LAS unsigned*)(lds + (bufoff) + ldsw + _i * 8192), 16, 0, 0); } while (0)
#define PG8_LDA(dst, b, h) do { _Pragma("unroll") for (int m = 0; m < 4; ++m) _Pragma("unroll") for (int k = 0; k < 2; ++k) dst[m][k] = *(const PG8_LAS bf16x8*)(lds + PG8_SA(b, h) + aoff + m * 2048 + k * 1024); } while (0)
#define PG8_LDB(dst, b, h) do { _Pragma("unroll") for (int n = 0; n < 2; ++n) _Pragma("unroll") for (int k = 0; k < 2; ++k) dst[n][k] = *(const PG8_LAS bf16x8*)(lds + PG8_SB(b, h) + boff + n * 2048 + k * 1024); } while (0)
#define PG8_MMA(ai, bj, At, Bt) do { __builtin_amdgcn_s_setprio(1); _Pragma("unroll") for (int m = 0; m < 4; ++m) _Pragma("unroll") for (int n = 0; n < 2; ++n) _Pragma("unroll") for (int k = 0; k < 2; ++k) \
        acc[ai][bj][m][n] = __builtin_amdgcn_mfma_f32_16x16x32_bf16(Bt[n][k], At[m][k], acc[ai][bj][m][n], 0, 0, 0); __builtin_amdgcn_s_setprio(0); } while (0)
#define PG8_WAIT_V(n) asm volatile("s_waitcnt vmcnt(" #n ")" ::: "memory")
#define PG8_WAIT_L(n) asm volatile("s_waitcnt lgkmcnt(" #n ")" ::: "memory")
#define PG8_BAR __builtin_amdgcn_s_barrier()
#define PG8_SCHED __builtin_amdgcn_sched_barrier(0)
    Unit cur, nxt; int ui = 0;
    if (!S.next(0, cur)) return;
    f32x4 acc[2][2][4][2];
#pragma unroll
    for (int a = 0; a < 2; ++a)
#pragma unroll
        for (int b = 0; b < 2; ++b)
#pragma unroll
            for (int m = 0; m < 4; ++m)
#pragma unroll
                for (int n = 0; n < 2; ++n) acc[a][b][m][n] = (f32x4){0.f, 0.f, 0.f, 0.f};
    bf16x8 At[4][2], B0[2][2], B1[2][2];
    const char* cA = (const char*)g.A + (size_t)cur.pm * tstepA + (size_t)cur.pb * g.sA; const char* cB = (const char*)g.Bt + (size_t)cur.pn * tstepB + (size_t)cur.pb * g.sB;
    S.a_ready(cur);
    if constexpr (SP2) {
        PG8_STAGE(PG8_SB(0, 0), cB, voffB); PG8_STAGE(PG8_SB(0, 1), cB + hstepB, voffB); PG8_STAGE(PG8_SA(0, 0), cA, voffA); PG8_STAGE(PG8_SA(0, 1), cA + hstepA, voffA);
        if (wr == 1) PG8_BAR;
        PG8_WAIT_V(2); PG8_BAR;
        PG8_STAGE(PG8_SB(1, 0), cB + kstep, voffB); PG8_STAGE(PG8_SA(1, 0), cA + kstep, voffA); PG8_STAGE(PG8_SB(1, 1), cB + hstepB + kstep, voffB);
        PG8_WAIT_V(6); PG8_BAR;
    } else {
        PG8_STAGE(PG8_SB(0, 0), cB, voffB); PG8_STAGE(PG8_SA(0, 0), cA, voffA); PG8_STAGE(PG8_SB(0, 1), cB + hstepB, voffB); PG8_STAGE(PG8_SA(0, 1), cA + hstepA, voffA);
        if (wr == 1) PG8_BAR;
        PG8_WAIT_V(4); PG8_BAR;
        PG8_STAGE(PG8_SB(1, 0), cB + kstep, voffB); PG8_STAGE(PG8_SA(1, 0), cA + kstep, voffA); PG8_STAGE(PG8_SB(1, 1), cB + hstepB + kstep, voffB);
        PG8_WAIT_V(6); PG8_BAR;
    }
    for (;;) {
        const bool has_next = S.next(ui + 1, nxt);
        const char* nA = has_next ? (const char*)g.A + (size_t)nxt.pm * tstepA + (size_t)nxt.pb * g.sA : cA; const char* nB = has_next ? (const char*)g.Bt + (size_t)nxt.pn * tstepB + (size_t)nxt.pb * g.sB : cB;
        for (int t = 0; t < nt; t += 2) {
            const bool last = (t == nt - 2);
            const char* a1 = cA + (size_t)(t + 1) * kstep;
            const char* a2 = last ? nA : cA + (size_t)(t + 2) * kstep; const char* b2 = last ? nB : cB + (size_t)(t + 2) * kstep;
            const char* a3 = a2 + kstep; const char* b3 = b2 + kstep;
            if (last && has_next) S.a_ready(nxt);
            if constexpr (SP2) {
            PG8_LDB(B0, 0, 0); PG8_LDB(B1, 0, 1); PG8_SCHED; PG8_LDA(At, 0, 0); PG8_STAGE(PG8_SA(1, 1), a1 + hstepA, voffA);
            PG8_WAIT_V(8); PG8_WAIT_L(0); PG8_BAR; PG8_MMA(0, 0, At, B0); PG8_MMA(0, 1, At, B1); PG8_BAR; PG8_SCHED;
            PG8_LDA(At, 0, 1); PG8_STAGE(PG8_SB(0, 0), b2, voffB); PG8_STAGE(PG8_SB(0, 1), b2 + hstepB, voffB); PG8_STAGE(PG8_SA(0, 0), a2, voffA);
            PG8_WAIT_V(8); PG8_WAIT_L(0); PG8_BAR; PG8_MMA(1, 0, At, B0); PG8_MMA(1, 1, At, B1); PG8_BAR; PG8_SCHED;
            PG8_LDB(B0, 1, 0); PG8_LDB(B1, 1, 1); PG8_SCHED; PG8_LDA(At, 1, 0); PG8_STAGE(PG8_SA(0, 1), a2 + hstepA, voffA);
            PG8_WAIT_V(8); PG8_WAIT_L(0); PG8_BAR; PG8_MMA(0, 0, At, B0); PG8_MMA(0, 1, At, B1); PG8_BAR; PG8_SCHED;
            PG8_LDA(At, 1, 1); PG8_STAGE(PG8_SB(1, 0), b3, voffB); PG8_STAGE(PG8_SB(1, 1), b3 + hstepB, voffB); PG8_STAGE(PG8_SA(1, 0), a3, voffA);
            PG8_WAIT_V(8); PG8_WAIT_L(0); PG8_BAR; PG8_MMA(1, 0, At, B0); PG8_MMA(1, 1, At, B1); PG8_BAR; PG8_SCHED;
            } else {
            PG8_LDB(B0, 0, 0); PG8_SCHED; PG8_LDA(At, 0, 0); PG8_STAGE(PG8_SA(1, 1), a1 + hstepA, voffA);
            PG8_WAIT_L(8); PG8_BAR; PG8_WAIT_L(0); PG8_MMA(0, 0, At, B0); PG8_BAR; PG8_SCHED;
            PG8_LDB(B1, 0, 1); PG8_STAGE(PG8_SB(0, 0), b2, voffB);
            PG8_BAR; PG8_WAIT_L(0); PG8_MMA(0, 1, At, B1); PG8_BAR;
            PG8_LDA(At, 0, 1); PG8_STAGE(PG8_SA(0, 0), a2, voffA);
            PG8_BAR; PG8_WAIT_L(0); PG8_MMA(1, 0, At, B0); PG8_BAR; PG8_SCHED;
            PG8_STAGE(PG8_SB(0, 1), b2 + hstepB, voffB);
            PG8_WAIT_V(6); PG8_BAR; PG8_MMA(1, 1, At, B1); PG8_BAR;
            PG8_LDB(B0, 1, 0); PG8_SCHED; PG8_LDA(At, 1, 0); PG8_STAGE(PG8_SA(0, 1), a2 + hstepA, voffA);
            PG8_WAIT_L(8); PG8_BAR; PG8_WAIT_L(0); PG8_MMA(0, 0, At, B0); PG8_BAR; PG8_SCHED;
            PG8_LDB(B1, 1, 1); PG8_STAGE(PG8_SB(1, 0), b3, voffB);
            PG8_BAR; PG8_WAIT_L(0); PG8_MMA(0, 1, At, B1); PG8_BAR;
            PG8_LDA(At, 1, 1); PG8_STAGE(PG8_SA(1, 0), a3, voffA);
            PG8_BAR; PG8_WAIT_L(0); PG8_MMA(1, 0, At, B0); PG8_BAR; PG8_SCHED;
            PG8_STAGE(PG8_SB(1, 1), b3 + hstepB, voffB);
            PG8_WAIT_V(6); PG8_BAR; PG8_MMA(1, 1, At, B1); PG8_BAR;
            }
        }
        if constexpr (ALIGN_EPI) { if (wr == 0) PG8_BAR; }
        if constexpr (!Epi::AFTER_DRAIN) { E(acc, cur, wr, wc, fr, fq); S.done(cur); }
        if (!has_next) break;
#pragma unroll
        for (int a = 0; a < 2; ++a)
#pragma unroll
            for (int b = 0; b < 2; ++b)
#pragma unroll
                for (int m = 0; m < 4; ++m)
#pragma unroll
                    for (int n = 0; n < 2; ++n) acc[a][b][m][n] = (f32x4){0.f, 0.f, 0.f, 0.f};
        cur = nxt; cA = nA; cB = nB; ++ui;
        if constexpr (ALIGN_EPI) { if (wr == 1) PG8_BAR; }
    }
    PG8_WAIT_V(0);
    if constexpr (!ALIGN_EPI) { if (wr == 0) PG8_BAR; }
    PG8_BAR;
    if constexpr (Epi::AFTER_DRAIN) { E.fused(acc, cur, wr, wc, fr, fq, lds, wid, lane); S.done(cur); }
#undef PG8_SA
#undef PG8_SB
#undef PG8_STAGE
#undef PG8_LDA
#undef PG8_LDB
#undef PG8_MMA
#undef PG8_WAIT_V
#undef PG8_WAIT_L
#undef PG8_BAR
#undef PG8_SCHED
}
}
using pg8::bf16_t; using pg8::bf16x8; using pg8::f32x4; using pg8::u32x4; using pg8::Unit;
#define LAS PG8_LAS
typedef unsigned u32x2 __attribute__((ext_vector_type(2)));
typedef short s16x4 __attribute__((ext_vector_type(4)));

constexpr int MTOK = 65536, DM = 1024, DFF = 2816, SEQL = 8192, CT = 32, NCHUNK = MTOK / CT  , NTHR = 512, NWAV = 8;
constexpr float RMS_EPS = 1e-6f;
constexpr size_t MiB = 1024ull * 1024ull;
constexpr size_t WS_XN = 0;
constexpr size_t WS_F = WS_XN + 128 * MiB;
constexpr size_t WS_BIG = WS_F + 128 * MiB;
constexpr size_t WS_ZS = WS_BIG, WS_SLOC = WS_BIG + 96 * MiB, WS_YG = WS_BIG + 160 * MiB;
constexpr size_t WS_WGU = WS_BIG + 384 * MiB;
constexpr size_t SZ_WGU = (size_t)5632 * 1024 * 2;
constexpr size_t WS_WD = WS_WGU + 8 * SZ_WGU;
constexpr size_t SZ_WD = (size_t)1024 * 2816 * 2;
constexpr size_t WS_WIN = WS_WD + 8 * SZ_WD;
constexpr size_t WS_WCAT = WS_WIN + 4 * MiB;
constexpr size_t WS_WGLU = WS_WCAT + 4 * MiB;
constexpr size_t WS_WQKV = WS_WGLU + 1 * MiB;
constexpr size_t WS_WO = WS_WQKV + 12 * MiB;
constexpr size_t WS_MTOEP = WS_WO + 4 * MiB;
constexpr size_t SZ_MTOEP = (size_t)512 * 768 * 2;
constexpr size_t WS_WST = WS_MTOEP + 64 * SZ_MTOEP;
constexpr size_t SZ_WST = (size_t)256 * 512 * 2;
constexpr size_t WS_LAMPOW = WS_WST + 64 * SZ_WST;
constexpr size_t WS_BBAR = WS_LAMPOW + 4 * MiB;
constexpr size_t WS_KTAB = WS_BBAR + 1 * MiB;
constexpr size_t WS_BAR = WS_KTAB + 4 * MiB;
constexpr size_t BAR_BYTES = 16384;
constexpr size_t WS_PCNT = WS_BAR + 14336;
constexpr size_t WS_RS = WS_BAR + BAR_BYTES;
constexpr size_t WS_XS = WS_RS + (size_t)MTOK * 16;
constexpr size_t WS_ATB = WS_XS + (size_t)MTOK * 16;
constexpr size_t WS_END = WS_ATB + 16 * MiB;
constexpr int LDS_BYTES = 131072 + 8192;

struct Args {
    const float *x, *norm_g, *w_gate, *w_up, *w_down, *ab_w_in, *pool_w, *pool_scale, *A_re, *A_im, *log_dt, *B_re, *B_im, *C_re, *C_im, *ssm_D, *w_glu, *b_glu, *ab_w_out, *w_qkv, *rpb, *na_w_out;
    float* out; unsigned char* ws; int ph_lo, ph_hi;
};

typedef const Args __attribute__((address_space(4)))* ArgsP;
__device__ __forceinline__ ArgsP args_ptr() { unsigned long long v = (unsigned long long)__builtin_amdgcn_kernarg_segment_ptr(); asm volatile("" : "+s"(v)); return (ArgsP)v; }
__device__ __forceinline__ unsigned cvt_pk_bf16(float lo, float hi) { unsigned r; asm volatile("v_cvt_pk_bf16_f32 %0, %1, %2" : "=v"(r) : "v"(lo), "v"(hi)); return r; }
__device__ __forceinline__ float bf_lo(unsigned w) { return __uint_as_float(w << 16); }
__device__ __forceinline__ float bf_hi(unsigned w) { return __uint_as_float(w & 0xffff0000u); }
__device__ __forceinline__ u32x4 pack8(const f32x4 a, const f32x4 b) { u32x4 w; w.x = cvt_pk_bf16(a[0], a[1]); w.y = cvt_pk_bf16(a[2], a[3]); w.z = cvt_pk_bf16(b[0], b[1]); w.w = cvt_pk_bf16(b[2], b[3]); return w; }
__device__ __forceinline__ float sigmoidf_(float v) { return __builtin_amdgcn_rcpf(1.0f + __builtin_amdgcn_exp2f(-1.4426950408889634f * v)); }
__device__ __forceinline__ float gelu_tanh(float v) { const float u = (1.5957691216057308f * 1.4426950408889634f) * (v + 0.044715f * v * v * v); return v * __builtin_amdgcn_rcpf(1.0f + __builtin_amdgcn_exp2f(-u)); }
__device__ __forceinline__ float wave_sum(float v) {
#pragma unroll
    for (int o = 1; o < 64; o <<= 1) v += __shfl_xor(v, o);
    return v;
}

#define XB_TMO      128
#define XB_XCNT(j)  (256  + 64 * (j))
#define XB_XSUB(j)  (1280 + 64 * (j))
#define XB_XGEN(j)  (2304 + 64 * (j))
#define XB_TOP      3328
#define XB_TOPGEN   3392
#define XCD_BAR_WORDS 3456
#define XB_SPIN_CAP (1u << 18)

__device__ __forceinline__ unsigned xb_ld(unsigned* p)              { return __hip_atomic_load(p, __ATOMIC_RELAXED, __HIP_MEMORY_SCOPE_AGENT); }
__device__ __forceinline__ unsigned xb_add(unsigned* p, unsigned v) { return __hip_atomic_fetch_add(p, v, __ATOMIC_RELAXED, __HIP_MEMORY_SCOPE_AGENT); }
__device__ __forceinline__ unsigned xb_xcc_id() { return (unsigned)__builtin_amdgcn_s_getreg((3 << 11) | 20) & 0xFu; }
#define XB_SPIN(cond, bar) do { unsigned _sp = 0; while (cond) { __builtin_amdgcn_s_sleep(1); \
    if ((++_sp & 255u) == 0u) { if (xb_ld(&(bar)[XB_TMO])) break; if (_sp > XB_SPIN_CAP) { atomicAdd(&(bar)[XB_TMO], 1u); break; } } } } while (0)

struct XcdBarrier {
    unsigned* bar; unsigned x;
    volatile LAS unsigned* st;
};

__device__ __forceinline__ XcdBarrier xcd_barrier_post(unsigned* bar, volatile LAS unsigned* st) {
    XcdBarrier b; b.bar = bar; b.x = xb_xcc_id(); b.st = st;
    if (threadIdx.x == 0) (void)xb_add(&bar[XB_XCNT(b.x)], 1u);
    return b;
}
__device__ __forceinline__ void xcd_barrier_complete(unsigned* bar, unsigned x, unsigned& nloc, unsigned& nx) {
    const unsigned G = gridDim.x * gridDim.y * gridDim.z;
    unsigned sum, cnt, mine, sp = 0u;
    for (;;) {
        sum = 0u; cnt = 0u; mine = 0u;
#pragma unroll
        for (unsigned j = 0; j < 16; ++j) { const unsigned c = xb_ld(&bar[XB_XCNT(j)]); sum += c; cnt += (c > 0u) ? 1u : 0u; mine = (j == x) ? c : mine; }
        if (sum == G) break;
        __builtin_amdgcn_s_sleep(1);
        if ((++sp & 255u) == 0u) { if (xb_ld(&bar[XB_TMO])) break; if (sp > XB_SPIN_CAP) { atomicAdd(&bar[XB_TMO], 1u); break; } }
    }
    nloc = mine > 0u ? mine : 1u; nx = cnt > 0u ? cnt : 1u;
}

__device__ __forceinline__ void xcd_barrier(const XcdBarrier& b) {
    asm volatile("s_waitcnt vmcnt(0)" ::: "memory");
    __syncthreads();
    if (threadIdx.x == 0) {
        unsigned* bar = b.bar;
        __builtin_amdgcn_s_waitcnt(0);
        unsigned nloc = b.st[0], nx = b.st[1];
        if (nloc == 0u) { xcd_barrier_complete(bar, b.x, nloc, nx); b.st[0] = nloc; b.st[1] = nx; }
        const unsigned old = xb_add(&bar[XB_XSUB(b.x)], 1u);
        const unsigned gen = old / nloc;
        if (old + 1u == (gen + 1u) * nloc) {
            __builtin_amdgcn_fence(__ATOMIC_RELEASE, "agent");
            asm volatile("s_waitcnt vmcnt(0)" ::: "memory");
            const unsigned og = xb_add(&bar[XB_TOP], 1u);
            const unsigned tg = og / nx;
            if (og + 1u == (tg + 1u) * nx) xb_add(&bar[XB_TOPGEN], 1u);
            else XB_SPIN(xb_ld(&bar[XB_TOPGEN]) == tg, bar);
            __builtin_amdgcn_fence(__ATOMIC_ACQUIRE, "agent");
            xb_add(&bar[XB_XGEN(b.x)], 1u);
            asm volatile("s_waitcnt vmcnt(0)" ::: "memory");
        } else {
            XB_SPIN(xb_ld(&bar[XB_XGEN(b.x)]) == gen, bar);
            __builtin_amdgcn_fence(__ATOMIC_ACQUIRE, "agent");
            asm volatile("s_waitcnt vmcnt(0)" ::: "memory");
        }
    }
    __syncthreads();
}

__device__ __forceinline__ void unpack8(const u32x4 w, float (&v)[8]) { v[0] = bf_lo(w.x); v[1] = bf_hi(w.x); v[2] = bf_lo(w.y); v[3] = bf_hi(w.y); v[4] = bf_lo(w.z); v[5] = bf_hi(w.z); v[6] = bf_lo(w.w); v[7] = bf_hi(w.w); }
__device__ __forceinline__ float row_rs(const float* RSP, int row) { const f32x4 p = *(const f32x4*)(RSP + (size_t)row * 4); return rsqrtf(((p[0] + p[1]) + (p[2] + p[3])) * (1.0f / DM) + RMS_EPS); }
__device__ __forceinline__ void row_rs8(const float* RSP, int row0, float (&rs)[2][4]) {
    f32x4 p[2][4];
#pragma unroll
    for (int ai = 0; ai < 2; ++ai)
#pragma unroll
        for (int m = 0; m < 4; ++m) p[ai][m] = *(const f32x4*)(RSP + (size_t)(row0 + ai * 128 + m * 16) * 4);
#pragma unroll
    for (int ai = 0; ai < 2; ++ai)
#pragma unroll
        for (int m = 0; m < 4; ++m) rs[ai][m] = rsqrtf(((p[ai][m][0] + p[ai][m][1]) + (p[ai][m][2] + p[ai][m][3])) * (1.0f / DM) + RMS_EPS);
    asm volatile("" : "+v"(rs[0][0]), "+v"(rs[0][1]), "+v"(rs[0][2]), "+v"(rs[0][3]), "+v"(rs[1][0]), "+v"(rs[1][1]), "+v"(rs[1][2]), "+v"(rs[1][3]));
}
__device__ __forceinline__ void rsl_fill(LAS float* rsl, const float* RSP, int bx, int tid) {
#pragma unroll
    for (int k = 0; k < 4; ++k) { const int pmk = 8 * ((bx % 8) * 4 + k) + ((bx / 8) % 8); if (tid < 256) rsl[k * 256 + tid] = row_rs(RSP, pmk * 256 + tid); }
    __syncthreads();
}
__device__ __forceinline__ void rsl_read(const LAS float* RSL, int pm, int wr, int fr, float (&rs)[2][4]) {
    int frl = fr; asm volatile("" : "+v"(frl));
    const LAS float* t = RSL + ((pm >> 3) & 3) * 256 + wr * 64 + frl;
#pragma unroll
    for (int ai = 0; ai < 2; ++ai)
#pragma unroll
        for (int m = 0; m < 4; ++m) rs[ai][m] = t[ai * 128 + m * 16];
}
struct EpiPlain {
    static constexpr bool PERM = true, AFTER_DRAIN = false;
    bf16_t* O; int ldc; const float* RS;
    __device__ __forceinline__ void operator()(const f32x4 (&acc)[2][2][4][2], const Unit& u, int wr, int wc, int fr, int fq) const {
        const int row0 = u.pm * 256 + wr * 64 + fr, col0 = u.pn * 256 + wc * 32 + 8 * fq;
        float rsv[2][4];
        if (RS) row_rs8(RS, row0, rsv);
#pragma unroll
        for (int ai = 0; ai < 2; ++ai)
#pragma unroll
            for (int m = 0; m < 4; ++m) { const int row = row0 + ai * 128 + m * 16; bf16_t* rowp = O + (size_t)row * ldc + col0; const float rs = RS ? rsv[ai][m] : 1.0f;
#pragma unroll
                for (int bj = 0; bj < 2; ++bj) *(u32x4*)(rowp + bj * 128) = pack8(acc[ai][bj][m][0] * rs, acc[ai][bj][m][1] * rs); }
    }
};
struct EpiQKV {
    static constexpr bool PERM = true, AFTER_DRAIN = false;
    bf16_t* O; const LAS float* RSL;
    __device__ __forceinline__ void operator()(const f32x4 (&acc)[2][2][4][2], const Unit& u, int wr, int wc, int fr, int fq) const {
        const int row0 = u.pm * 256 + wr * 64 + fr;
        float rsv[2][4]; rsl_read(RSL, u.pm, wr, fr, rsv);
#pragma unroll
        for (int ai = 0; ai < 2; ++ai)
#pragma unroll
            for (int m = 0; m < 4; ++m) { const int row = row0 + ai * 128 + m * 16, b = row >> 13, t = row & (SEQL - 1); const float rs = rsv[ai][m];
#pragma unroll
                for (int bj = 0; bj < 2; ++bj) { const int col = u.pn * 256 + bj * 128 + wc * 32 + 8 * fq, which = col >> 10, hc = col & 1023, h = hc >> 6, dd = hc & 63;
                    *(u32x4*)(O + (size_t)which * ((size_t)MTOK * DM) + ((size_t)(b * 16 + h) * SEQL + t) * 64 + dd) = pack8(acc[ai][bj][m][0] * rs, acc[ai][bj][m][1] * rs); } }
    }
};
struct EpiSwiglu {
    static constexpr bool PERM = true, AFTER_DRAIN = false;
    bf16_t* O; const LAS float* RSL;
    __device__ __forceinline__ void operator()(const f32x4 (&acc)[2][2][4][2], const Unit& u, int wr, int wc, int fr, int fq) const {
        const int row0 = u.pm * 256 + wr * 64 + fr, col0 = u.pn * 128 + wc * 32 + 8 * fq;
        float rsv[2][4]; { int frl = fr; asm volatile("" : "+v"(frl));
            const LAS float* t = RSL + ((u.pm >> 3) & 3) * 256 + wr * 64 + frl;
#pragma unroll
            for (int ai = 0; ai < 2; ++ai)
#pragma unroll
                for (int m = 0; m < 4; ++m) rsv[ai][m] = t[ai * 128 + m * 16]; }
#pragma unroll
        for (int ai = 0; ai < 2; ++ai)
#pragma unroll
            for (int m = 0; m < 4; ++m) { f32x4 v[2]; const float rs = rsv[ai][m], rsl = rs * -1.4426950408889634f, rs2 = rs * rs;
#pragma unroll
                for (int n = 0; n < 2; ++n) {
                    const f32x4 gt = acc[ai][0][m][n], up = acc[ai][1][m][n]; const f32x4 pr = gt * up, ar = gt * rsl; f32x4 ex;
#pragma unroll
                    for (int e = 0; e < 4; ++e) ex[e] = __builtin_amdgcn_exp2f(ar[e]);
                    const f32x4 dn = ex + 1.0f; f32x4 rc;
#pragma unroll
                    for (int e = 0; e < 4; ++e) rc[e] = __builtin_amdgcn_rcpf(dn[e]);
                    v[n] = (pr * rs2) * rc; }
                __builtin_nontemporal_store(pack8(v[0], v[1]), (u32x4*)(O + (size_t)(row0 + ai * 128 + m * 16) * DFF + col0)); }
    }
};
struct EpiZ {
    static constexpr bool PERM = true, AFTER_DRAIN = false;
    bf16_t* ZP; bf16_t* ZS; const LAS float* RSL;
    __device__ __forceinline__ void operator()(const f32x4 (&acc)[2][2][4][2], const Unit& u, int wr, int wc, int fr, int fq) const {
        const int row0 = u.pm * 256 + wr * 64 + fr;
        float rsv[2][4]; rsl_read(RSL, u.pm, wr, fr, rsv);
#pragma unroll
        for (int ai = 0; ai < 2; ++ai)
#pragma unroll
            for (int m = 0; m < 4; ++m) { const int row = row0 + ai * 128 + m * 16; const float rs = rsv[ai][m];
#pragma unroll
                for (int bj = 0; bj < 2; ++bj) { const int col = u.pn * 256 + bj * 128 + wc * 32 + 8 * fq; const u32x4 w = pack8(acc[ai][bj][m][0] * rs, acc[ai][bj][m][1] * rs);
                    if (u.pn < 2) *(u32x4*)(ZP + (size_t)row * 512 + col) = w;
                    else { const int cs = col - 512, g = cs >> 4, h0 = cs & 15; *(u32x4*)(ZS + ((size_t)g * NCHUNK + (row >> 5)) * 768 + (row & 31) * 16 + h0) = w; } } }
    }
};
struct EpiState {
    static constexpr bool PERM = true, AFTER_DRAIN = false;
    float* S;
    __device__ __forceinline__ void operator()(const f32x4 (&acc)[2][2][4][2], const Unit& u, int wr, int wc, int fr, int fq) const {
        const int row0 = u.pm * 256 + wr * 64 + fr, col0 = wc * 32 + 8 * fq;
#pragma unroll
        for (int ai = 0; ai < 2; ++ai)
#pragma unroll
            for (int m = 0; m < 4; ++m) { float* rowp = S + ((size_t)u.pb * NCHUNK + row0 + ai * 128 + m * 16) * 256 + col0;
#pragma unroll
                for (int bj = 0; bj < 2; ++bj) { *(f32x4*)(rowp + bj * 128) = acc[ai][bj][m][0]; *(f32x4*)(rowp + bj * 128 + 4) = acc[ai][bj][m][1]; } }
    }
};
struct EpiSsmOut {
    static constexpr bool PERM = true, AFTER_DRAIN = false;
    bf16_t* YG;
    __device__ __forceinline__ void operator()(const f32x4 (&acc)[2][2][4][2], const Unit& u, int wr, int wc, int fr, int fq) const {
        const int row0 = u.pm * 256 + wr * 64 + fr;
#pragma unroll
        for (int ai = 0; ai < 2; ++ai)
#pragma unroll
            for (int m = 0; m < 4; ++m) { const int crow = row0 + ai * 128 + m * 16;
#pragma unroll
                for (int bj = 0; bj < 2; ++bj) { const int col = u.pn * 256 + bj * 128 + wc * 32 + 8 * fq, t = col >> 4, h0 = col & 15; f32x4 v[2];
#pragma unroll
                    for (int n = 0; n < 2; ++n)
#pragma unroll
                        for (int e = 0; e < 4; ++e) v[n][e] = gelu_tanh(acc[ai][bj][m][n][e]);
                    *(u32x4*)(YG + ((size_t)crow * CT + t) * 512 + u.pb * 16 + h0) = pack8(v[0], v[1]); } }
    }
};
struct EpiGlu {
    static constexpr bool PERM = true, AFTER_DRAIN = false;
    const bf16_t* YG; const float* bias; bf16_t* CAT;
    __device__ __forceinline__ void operator()(const f32x4 (&acc)[2][2][4][2], const Unit& u, int wr, int wc, int fr, int fq) const {
        const int row0 = u.pm * 256 + wr * 64 + fr;
        u32x4 yv[2][2][4]; f32x4 bv[2][2];
#pragma unroll
        for (int bj = 0; bj < 2; ++bj) { const int col = u.pn * 256 + bj * 128 + wc * 32 + 8 * fq; bv[bj][0] = *(const f32x4*)(bias + col); bv[bj][1] = *(const f32x4*)(bias + col + 4);
#pragma unroll
            for (int ai = 0; ai < 2; ++ai)
#pragma unroll
                for (int m = 0; m < 4; ++m) yv[bj][ai][m] = *(const u32x4*)(YG + (size_t)(row0 + ai * 128 + m * 16) * 512 + col); }
        asm volatile("" ::: "memory");
#pragma unroll
        for (int bj = 0; bj < 2; ++bj) { const int col = u.pn * 256 + bj * 128 + wc * 32 + 8 * fq;
#pragma unroll
            for (int ai = 0; ai < 2; ++ai)
#pragma unroll
                for (int m = 0; m < 4; ++m) { const int row = row0 + ai * 128 + m * 16; const u32x4 y = yv[bj][ai][m];
                    f32x4 v0, v1; const f32x4 a0 = acc[ai][bj][m][0] + bv[bj][0], a1 = acc[ai][bj][m][1] + bv[bj][1];
                    v0[0] = bf_lo(y.x) * sigmoidf_(a0[0]); v0[1] = bf_hi(y.x) * sigmoidf_(a0[1]); v0[2] = bf_lo(y.y) * sigmoidf_(a0[2]); v0[3] = bf_hi(y.y) * sigmoidf_(a0[3]);
                    v1[0] = bf_lo(y.z) * sigmoidf_(a1[0]); v1[1] = bf_hi(y.z) * sigmoidf_(a1[1]); v1[2] = bf_lo(y.w) * sigmoidf_(a1[2]); v1[3] = bf_hi(y.w) * sigmoidf_(a1[3]);
                    *(u32x4*)(CAT + (size_t)row * 1024 + 512 + col) = pack8(v0, v1); } }
    }
};

struct EpiResNorm {
    static constexpr bool PERM = true, AFTER_DRAIN = false;
    bf16_t* HB; const float* ga; float alpha; float* XS; float* RSP; unsigned* cnt; unsigned need; float* OUT; LAS unsigned char* misc;
    __device__ __forceinline__ void operator()(const f32x4 (&acc)[2][2][4][2], const Unit& u, int wr, int wc, int fr, int fq) const {
        LAS float* P = (LAS float*)misc; LAS float* S = (LAS float*)(misc + 4096);
        const int tid = threadIdx.x, rloc0 = wr * 64 + fr, colb = u.pn * 256 + wc * 32 + 8 * fq; const size_t grow0 = (size_t)u.pm * 256;
        f32x4 g[2][2];
#pragma unroll
        for (int bj = 0; bj < 2; ++bj) { g[bj][0] = *(const f32x4*)(ga + colb + bj * 128); g[bj][1] = *(const f32x4*)(ga + colb + bj * 128 + 4); }
        u32x4 pre[4][2];
#pragma unroll
        for (int m = 0; m < 4; ++m)
#pragma unroll
            for (int bj = 0; bj < 2; ++bj) pre[m][bj] = *(const u32x4*)(HB + (grow0 + rloc0 + m * 16) * DM + colb + bj * 128);
#pragma unroll
        for (int ai = 0; ai < 2; ++ai)
#pragma unroll
            for (int m = 0; m < 4; ++m) { float q = 0.f;
#pragma unroll
                for (int bj = 0; bj < 2; ++bj)
#pragma unroll
                    for (int n = 0; n < 2; ++n) { const f32x4 x = acc[ai][bj][m][n]; q += (x[0] * x[0] + x[1] * x[1]) + (x[2] * x[2] + x[3] * x[3]); }
                q += __shfl_xor(q, 16); q += __shfl_xor(q, 32);
                if (fq == 0) P[(rloc0 + ai * 128 + m * 16) * 4 + wc] = q; }
        asm volatile("s_waitcnt lgkmcnt(0)" ::: "memory"); __builtin_amdgcn_s_barrier(); asm volatile("" ::: "memory");
        if (tid < 256) { const float tot = (P[tid * 4 + 0] + P[tid * 4 + 1]) + (P[tid * 4 + 2] + P[tid * 4 + 3]);
            __hip_atomic_store((unsigned*)(XS + (grow0 + tid) * 4 + u.pn), __float_as_uint(tot), __ATOMIC_RELAXED, __HIP_MEMORY_SCOPE_AGENT); }
        asm volatile("s_waitcnt vmcnt(0) lgkmcnt(0)" ::: "memory"); __builtin_amdgcn_s_barrier(); asm volatile("" ::: "memory");
        if (tid == 0) { (void)__hip_atomic_fetch_add(cnt + u.pm, 1u, __ATOMIC_RELAXED, __HIP_MEMORY_SCOPE_AGENT); unsigned sp = 0;
            while (__hip_atomic_load(cnt + u.pm, __ATOMIC_RELAXED, __HIP_MEMORY_SCOPE_AGENT) < need) { __builtin_amdgcn_s_sleep(1); if (++sp > (1u << 22)) break; } }
        asm volatile("s_waitcnt vmcnt(0) lgkmcnt(0)" ::: "memory"); __builtin_amdgcn_s_barrier(); asm volatile("" ::: "memory");
        if (tid < 256) { float ss = 0.f;
#pragma unroll
            for (int t = 0; t < 4; ++t) ss += __uint_as_float(__hip_atomic_load((unsigned*)(XS + (grow0 + tid) * 4 + t), __ATOMIC_RELAXED, __HIP_MEMORY_SCOPE_AGENT));
            S[tid] = alpha * rsqrtf(ss * (1.0f / DM) + RMS_EPS); }
        asm volatile("s_waitcnt lgkmcnt(0)" ::: "memory"); __builtin_amdgcn_s_barrier(); asm volatile("" ::: "memory");
#pragma unroll
        for (int ai = 0; ai < 2; ++ai)
#pragma unroll
            for (int m = 0; m < 4; ++m) { const int rloc = rloc0 + ai * 128 + m * 16; const float rs = S[rloc]; float q2 = 0.f;
                u32x4 cur[2]; cur[0] = pre[m][0]; cur[1] = pre[m][1];
                if (ai == 0) {
#pragma unroll
                    for (int bj = 0; bj < 2; ++bj) pre[m][bj] = *(const u32x4*)(HB + (grow0 + rloc + 128) * DM + colb + bj * 128); }
#pragma unroll
                for (int bj = 0; bj < 2; ++bj) { float h[8]; unpack8(cur[bj], h);
#pragma unroll
                    for (int e = 0; e < 4; ++e) { h[e] += acc[ai][bj][m][0][e] * g[bj][0][e] * rs; h[4 + e] += acc[ai][bj][m][1][e] * g[bj][1][e] * rs; }
                    if (OUT) { float* op = OUT + (grow0 + rloc) * DM + colb + bj * 128; *(f32x4*)op = (f32x4){h[0], h[1], h[2], h[3]}; *(f32x4*)(op + 4) = (f32x4){h[4], h[5], h[6], h[7]}; }
                    else { u32x4 w; w.x = cvt_pk_bf16(h[0], h[1]); w.y = cvt_pk_bf16(h[2], h[3]); w.z = cvt_pk_bf16(h[4], h[5]); w.w = cvt_pk_bf16(h[6], h[7]);
                        *(u32x4*)(HB + (grow0 + rloc) * DM + colb + bj * 128) = w; float qv[8]; unpack8(w, qv);
#pragma unroll
                        for (int e = 0; e < 8; ++e) q2 += qv[e] * qv[e]; } }
                q2 += __shfl_xor(q2, 16); q2 += __shfl_xor(q2, 32);
                if (fq == 0) P[rloc * 4 + wc] = q2; }
        asm volatile("s_waitcnt lgkmcnt(0)" ::: "memory"); __builtin_amdgcn_s_barrier(); asm volatile("" ::: "memory");
        if (tid < 256 && !OUT) RSP[(grow0 + tid) * 4 + u.pn] = (P[tid * 4 + 0] + P[tid * 4 + 1]) + (P[tid * 4 + 2] + P[tid * 4 + 3]);
        asm volatile("s_waitcnt lgkmcnt(0)" ::: "memory");
    }
};
struct BatchOrder {
    int nM, nN, nB, G, c;
    __device__ void init(int M, int N, int B, int G_, int c_) { nM = M / 256; nN = N / 256; nB = B; G = G_; c = c_; }
    __device__ bool next(int i, Unit& u) const { const int L = i * G + c; if (L >= nM * nN * nB) return false; u.pb = L / (nM * nN); const int r = L % (nM * nN); u.pn = r / nM; u.pm = r % nM; return true; }
    __device__ __forceinline__ void a_ready(const Unit&) const {}
    __device__ __forceinline__ void done(const Unit&) const {}
};
__device__ __forceinline__ void rowwise_phase(const float* X, bf16_t* HB, const bf16_t* F, const float* ga, float alpha, float* RS, float* OUT, int gw, int NGW, int lane) {
    for (int row0 = gw; row0 < MTOK; row0 += 4 * NGW) {
        float h[4][2][8]; u32x4 fw[4][2];
#pragma unroll
        for (int r = 0; r < 4; ++r) { const int row = row0 + r * NGW;
#pragma unroll
            for (int j = 0; j < 2; ++j) {
                if (X) { const f32x4 a0 = *(const f32x4*)(X + (size_t)row * DM + 8 * lane + 512 * j), a1 = *(const f32x4*)(X + (size_t)row * DM + 8 * lane + 512 * j + 4);
                    h[r][j][0] = a0[0]; h[r][j][1] = a0[1]; h[r][j][2] = a0[2]; h[r][j][3] = a0[3]; h[r][j][4] = a1[0]; h[r][j][5] = a1[1]; h[r][j][6] = a1[2]; h[r][j][7] = a1[3]; }
                else { const u32x4 w = *(const u32x4*)(HB + (size_t)row * DM + 8 * lane + 512 * j); unpack8(w, h[r][j]); }
                if (F) fw[r][j] = *(const u32x4*)(F + (size_t)row * DM + 8 * lane + 512 * j); } }
#pragma unroll
        for (int r = 0; r < 4; ++r) { const int row = row0 + r * NGW;
            if (F) { float f[2][8]; float ss = 0.f;
#pragma unroll
                for (int j = 0; j < 2; ++j) { unpack8(fw[r][j], f[j]);
#pragma unroll
                    for (int e = 0; e < 8; ++e) ss += f[j][e] * f[j][e]; }
                const float rs = alpha * rsqrtf(wave_sum(ss) * (1.0f / DM) + RMS_EPS);
#pragma unroll
                for (int j = 0; j < 2; ++j) { const f32x4 g0 = *(const f32x4*)(ga + 8 * lane + 512 * j), g1 = *(const f32x4*)(ga + 8 * lane + 512 * j + 4);
#pragma unroll
                    for (int e = 0; e < 4; ++e) { h[r][j][e] += f[j][e] * g0[e] * rs; h[r][j][4 + e] += f[j][4 + e] * g1[e] * rs; } } }
            if (OUT) {
#pragma unroll
                for (int j = 0; j < 2; ++j) { *(f32x4*)(OUT + (size_t)row * DM + 8 * lane + 512 * j) = (f32x4){h[r][j][0], h[r][j][1], h[r][j][2], h[r][j][3]}; *(f32x4*)(OUT + (size_t)row * DM + 8 * lane + 512 * j + 4) = (f32x4){h[r][j][4], h[r][j][5], h[r][j][6], h[r][j][7]}; }
            } else { float ss = 0.f;
#pragma unroll
                for (int j = 0; j < 2; ++j) { u32x4 w; w.x = cvt_pk_bf16(h[r][j][0], h[r][j][1]); w.y = cvt_pk_bf16(h[r][j][2], h[r][j][3]); w.z = cvt_pk_bf16(h[r][j][4], h[r][j][5]); w.w = cvt_pk_bf16(h[r][j][6], h[r][j][7]);
                    *(u32x4*)(HB + (size_t)row * DM + 8 * lane + 512 * j) = w; float q[8]; unpack8(w, q);
#pragma unroll
                    for (int e = 0; e < 8; ++e) ss += q[e] * q[e]; }
                ss = wave_sum(ss); if (lane == 0) *(f32x4*)(RS + (size_t)row * 4) = (f32x4){ss, 0.f, 0.f, 0.f}; }
        }
    }
}

struct TItem { const float* W; bf16_t* WT; const float* gk; int ldw, k0, n0, ldt, orow0; float scale; };
__device__ __forceinline__ TItem titem_decode(ArgsP a, int it) {
    constexpr int I_FFN = 4224, N_FFN = 8 * I_FFN, I_MIX = 2944;
    const float* W; int ldw, nblk, ldt, orow_add = 0, r; bf16_t* WT; float scale = 1.f; bool il = false; const float* gk = nullptr;
    if (it < N_FFN) { const int f = it / I_FFN; r = it % I_FFN; const int which = r / 1408; r = r % 1408; if (which < 2) gk = a->norm_g + (size_t)((f >> 1) * 6 + ((f & 1) ? 4 : 0)) * DM;
        if (which == 0) { W = a->w_gate + (size_t)f * DM * DFF; ldw = DFF; nblk = 88; WT = (bf16_t*)(a->ws + WS_WGU + f * SZ_WGU); ldt = DM; il = true; }
        else if (which == 1) { W = a->w_up + (size_t)f * DM * DFF; ldw = DFF; nblk = 88; WT = (bf16_t*)(a->ws + WS_WGU + f * SZ_WGU); ldt = DM; il = true; orow_add = 128; }
        else { W = a->w_down + (size_t)f * DFF * DM; ldw = DM; nblk = 32; WT = (bf16_t*)(a->ws + WS_WD + f * SZ_WD); ldt = DFF; }
    } else { const int it2 = it - N_FFN, i = it2 / I_MIX; r = it2 % I_MIX;
        if (r < 512) { gk = a->norm_g + (size_t)((2 * i) * 6 + 2) * DM; W = a->ab_w_in + (size_t)i * DM * DM; ldw = DM; nblk = 32; WT = (bf16_t*)(a->ws + WS_WIN) + (size_t)i * DM * DM; ldt = DM; }
        else if (r < 768) { r -= 512; W = a->ab_w_out + (size_t)i * DM * DM + (size_t)512 * DM; ldw = DM; nblk = 32; WT = (bf16_t*)(a->ws + WS_WCAT) + (size_t)i * DM * DM + 512; ldt = DM; }
        else if (r < 896) { r -= 768; W = a->w_glu + (size_t)i * 512 * 512; ldw = 512; nblk = 16; WT = (bf16_t*)(a->ws + WS_WGLU) + (size_t)i * 512 * 512; ldt = 512; }
        else if (r < 2432) { r -= 896; gk = a->norm_g + (size_t)((2 * i + 1) * 6 + 2) * DM; W = a->w_qkv + (size_t)i * DM * 3072; ldw = 3072; nblk = 96; WT = (bf16_t*)(a->ws + WS_WQKV) + (size_t)i * 3072 * DM; ldt = DM; if ((r % 96) < 32) scale = 0.125f * 1.4426950408889634f;     }
        else { r -= 2432; W = a->na_w_out + (size_t)i * DM * DM; ldw = DM; nblk = 32; WT = (bf16_t*)(a->ws + WS_WO) + (size_t)i * DM * DM; ldt = DM; }
    }
    const int kb = r / nblk, nb = r % nblk, n0 = 32 * nb;
    TItem t; t.W = W; t.WT = WT; t.gk = gk; t.ldw = ldw; t.k0 = 64 * kb; t.n0 = n0; t.ldt = ldt; t.orow0 = il ? ((n0 >> 7) * 256 + (n0 & 127) + orow_add) : n0; t.scale = scale; return t;
}
__device__ __forceinline__ void tile_load(const TItem& t, int lane, f32x4 (&v)[8], float (&gm)[8]) {
    const int n4 = lane & 7, kr = lane >> 3;
#pragma unroll
    for (int i = 0; i < 8; ++i) { v[i] = *(const f32x4*)(t.W + (size_t)(t.k0 + kr + 8 * i) * t.ldw + t.n0 + 4 * n4); gm[i] = t.gk ? t.gk[t.k0 + kr + 8 * i] : 1.0f; }
}
__device__ __forceinline__ void tile_store(const TItem& t, int lane, const f32x4 (&v)[8], const float (&gm)[8], LAS float* scr) {
    { const int n4 = lane & 7, kr = lane >> 3;
#pragma unroll
      for (int i = 0; i < 8; ++i) { LAS float* s = scr + (kr + 8 * i) * 33 + 4 * n4; s[0] = v[i][0] * gm[i]; s[1] = v[i][1] * gm[i]; s[2] = v[i][2] * gm[i]; s[3] = v[i][3] * gm[i]; } }
    asm volatile("s_waitcnt lgkmcnt(0)" ::: "memory");
    const int c = lane & 7;
#pragma unroll
    for (int j = 0; j < 4; ++j) { const int n = (lane >> 3) + 8 * j; const LAS float* s = scr + (8 * c) * 33 + n; const float scale = t.scale;
        u32x4 o; o.x = cvt_pk_bf16(s[0 * 33] * scale, s[1 * 33] * scale); o.y = cvt_pk_bf16(s[2 * 33] * scale, s[3 * 33] * scale); o.z = cvt_pk_bf16(s[4 * 33] * scale, s[5 * 33] * scale); o.w = cvt_pk_bf16(s[6 * 33] * scale, s[7 * 33] * scale);
        *(u32x4*)(t.WT + (size_t)(t.orow0 + n) * t.ldt + t.k0 + 8 * c) = o; }
    asm volatile("s_waitcnt lgkmcnt(0)" ::: "memory");
}
__device__ __forceinline__ void transposes_phase(ArgsP a, LAS float* scr, int gw, int NGW, int lane) {
    constexpr int N_ALL = 8 * 4224 + 2 * 2944;
    if (gw >= N_ALL) return;
    TItem cur = titem_decode(a, gw); f32x4 v[8]; float gm[8]; tile_load(cur, lane, v, gm);
    for (int it = gw; it < N_ALL; it += NGW) {
        const int nx = it + NGW; const bool has = nx < N_ALL; TItem nxt = cur; f32x4 vn[8]; float gn[8];
        if (has) { nxt = titem_decode(a, nx); tile_load(nxt, lane, vn, gn); }
        tile_store(cur, lane, v, gm, scr);
        if (has) { cur = nxt;
#pragma unroll
            for (int i = 0; i < 8; ++i) { v[i] = vn[i]; gm[i] = gn[i]; } }
    }
}

__device__ __forceinline__ void ssm_tables0(ArgsP a, int gt, int NGT) {
    float* LP = (float*)(a->ws + WS_LAMPOW); float* BB = (float*)(a->ws + WS_BBAR);
    for (int idx = gt; idx < 8192; idx += NGT) {
        const int q = idx >> 6, p = idx & 63;
        const float are = fminf(a->A_re[idx], -1e-4f), aim = a->A_im[idx], dt = expf(a->log_dt[q]);
        const float mag = expf(are * dt), lr = mag * cosf(aim * dt), li = mag * sinf(aim * dt);
        float pr = 1.f, pi = 0.f;
        for (int tau = 0; tau <= 32; ++tau) { *(float2*)(LP + ((size_t)(q * 33 + tau) * 64 + p) * 2) = make_float2(pr, pi); const float nr = pr * lr - pi * li, ni = pr * li + pi * lr; pr = nr; pi = ni; }
        const float nre = lr - 1.f, nim = li, den = are * are + aim * aim;
        const float fre = (nre * are + nim * aim) / den, fim = (nim * are - nre * aim) / den;
        for (int h = 0; h < 16; ++h) { const float br = a->B_re[(size_t)idx * 16 + h], bi = a->B_im[(size_t)idx * 16 + h];
            *(float2*)(BB + ((size_t)idx * 16 + h) * 2) = make_float2(fre * br - fim * bi, fre * bi + fim * br); }
    }
}
__device__ __forceinline__ void ssm_tables1(ArgsP a, int gt, int NGT) {
    const float2* LP = (const float2*)(a->ws + WS_LAMPOW); const float2* BB = (const float2*)(a->ws + WS_BBAR); float* KT = (float*)(a->ws + WS_KTAB);
    for (int o = gt; o < 128 * 32 * 256; o += NGT) {
        const int hp = o & 15, h = (o >> 4) & 15, tau = (o >> 8) & 31, q = o >> 13; float s = 0.f;
        for (int p = 0; p < 64; ++p) { const float cr = a->C_re[(size_t)q * 1024 + h * 64 + p], ci = a->C_im[(size_t)q * 1024 + h * 64 + p];
            const float2 l = LP[(size_t)(q * 33 + tau) * 64 + p], b = BB[((size_t)q * 64 + p) * 16 + hp];
            const float xr = l.x * b.x - l.y * b.y, xi = l.x * b.y + l.y * b.x; s += cr * xr - ci * xi; }
        KT[o] = s;
    }
    for (int o = gt; o < 2 * 32 * 256 * 64; o += NGT) {
        const int half = o & 1, s = (o >> 1) & 31, n = (o >> 6) & 255, ig = o >> 14, i = ig >> 5, g = ig & 31;
        const int dir = n >> 7, part = (n >> 6) & 1, p = n & 63, q = (i * 2 + dir) * 32 + g, e = dir == 0 ? 31 - s : s;
        const float2 l = LP[(size_t)(q * 33 + e) * 64 + p]; float v[8];
#pragma unroll
        for (int j = 0; j < 8; ++j) { const float2 b = BB[((size_t)q * 64 + p) * 16 + half * 8 + j]; v[j] = part == 0 ? (l.x * b.x - l.y * b.y) : (l.x * b.y + l.y * b.x); }
        u32x4 w; w.x = cvt_pk_bf16(v[0], v[1]); w.y = cvt_pk_bf16(v[2], v[3]); w.z = cvt_pk_bf16(v[4], v[5]); w.w = cvt_pk_bf16(v[6], v[7]);
        *(u32x4*)((bf16_t*)(a->ws + WS_WST + (size_t)ig * SZ_WST) + (size_t)n * 512 + s * 16 + half * 8) = w;
    }
    for (int o = gt; o < 2 * 32 * 512 * 32; o += NGT) {
        const int cblk = o & 31, n = (o >> 5) & 511, ig = o >> 14, i = ig >> 5, g = ig & 31;
        const int kind = cblk >> 3, p0 = (cblk & 7) * 8, dir = kind >> 1, q = (i * 2 + dir) * 32 + g, t = n >> 4, h = n & 15, e = dir == 0 ? t + 1 : 32 - t; float v[8];
#pragma unroll
        for (int j = 0; j < 8; ++j) { const int p = p0 + j; const float cr = a->C_re[(size_t)q * 1024 + h * 64 + p], ci = a->C_im[(size_t)q * 1024 + h * 64 + p]; const float2 l = LP[(size_t)(q * 33 + e) * 64 + p];
            v[j] = (kind & 1) == 0 ? (cr * l.x - ci * l.y) : -(cr * l.y + ci * l.x); }
        u32x4 w; w.x = cvt_pk_bf16(v[0], v[1]); w.y = cvt_pk_bf16(v[2], v[3]); w.z = cvt_pk_bf16(v[4], v[5]); w.w = cvt_pk_bf16(v[6], v[7]);
        *(u32x4*)((bf16_t*)(a->ws + WS_MTOEP + (size_t)ig * SZ_MTOEP) + (size_t)n * 768 + 512 + cblk * 8) = w;
    }
}
__device__ __forceinline__ void wcat_fold(ArgsP a, int gt, int NGT) {
    for (int o = gt; o < 2 * 4 * 16 * 1024; o += NGT) {
        const int n = o & 1023, c8 = (o >> 10) & 15, g = (o >> 14) & 3, i = o >> 16; float acc[8];
#pragma unroll
        for (int j = 0; j < 8; ++j) acc[j] = 0.f;
        const float* pw = a->pool_w + ((size_t)(i * 4 + g) * 128 + c8 * 8) * 128; const float* sc = a->pool_scale + i * 512 + g * 128; const float* wo = a->ab_w_out + (size_t)i * DM * DM + (size_t)(g * 128) * DM + n;
        for (int d = 0; d < 128; ++d) { const float x = sc[d] * wo[(size_t)d * DM];
#pragma unroll
            for (int j = 0; j < 8; ++j) acc[j] += pw[j * 128 + d] * x; }
        u32x4 w; w.x = cvt_pk_bf16(acc[0], acc[1]); w.y = cvt_pk_bf16(acc[2], acc[3]); w.z = cvt_pk_bf16(acc[4], acc[5]); w.w = cvt_pk_bf16(acc[6], acc[7]);
        *(u32x4*)((bf16_t*)(a->ws + WS_WCAT) + (size_t)i * DM * DM + (size_t)n * DM + g * 128 + c8 * 8) = w;
    }
}
__device__ __forceinline__ void ssm_tables2(ArgsP a, int gt, int NGT) {
    const float* KT = (const float*)(a->ws + WS_KTAB);
    for (int o = gt; o < 2 * 32 * 512 * 64; o += NGT) {
        const int half = o & 1, s = (o >> 1) & 31, n = (o >> 6) & 511, ig = o >> 15, i = ig >> 5, g = ig & 31, t = n >> 4, h = n & 15;
        const int qf = (i * 2) * 32 + g, qb = (i * 2 + 1) * 32 + g; float v[8];
#pragma unroll
        for (int j = 0; j < 8; ++j) v[j] = 0.f;
        if (s <= t) { const float* k = KT + ((size_t)(qf * 32 + (t - s)) * 16 + h) * 16 + half * 8;
#pragma unroll
            for (int j = 0; j < 8; ++j) v[j] += k[j]; }
        if (s >= t) { const float* k = KT + ((size_t)(qb * 32 + (s - t)) * 16 + h) * 16 + half * 8;
#pragma unroll
            for (int j = 0; j < 8; ++j) v[j] += k[j]; }
        if (s == t) { const float dsk = a->ssm_D[i * 512 + g * 16 + h];
#pragma unroll
            for (int j = 0; j < 8; ++j) if (half * 8 + j == h) v[j] += dsk; }
        u32x4 w; w.x = cvt_pk_bf16(v[0], v[1]); w.y = cvt_pk_bf16(v[2], v[3]); w.z = cvt_pk_bf16(v[4], v[5]); w.w = cvt_pk_bf16(v[6], v[7]);
        *(u32x4*)((bf16_t*)(a->ws + WS_MTOEP + (size_t)ig * SZ_MTOEP) + (size_t)n * 768 + s * 16 + half * 8) = w;
    }
}

__device__ __forceinline__ void attn_table(ArgsP a, int gt, int NGT) {
    float* TB = (float*)(a->ws + WS_ATB);
    for (int o = gt; o < 2 * 8 * 16 * 4 * 16 * 64; o += NGT) {
        const int lane = o & 63, it = (o >> 6) & 15, qt = (o >> 10) & 3, h = (o >> 12) & 15, v = (o >> 16) & 7, i = o >> 19;
        const int ii = it >> 1, t = it & 1, fr = lane & 15, fq = lane >> 4, kc0 = qt == 0 ? 0 : (qt == 1 ? 8 : (qt == 2 ? 24 : 32));
        const int c = 16 * qt + fr, cs = min(max(c - 8, 0), 48); f32x4 w;
#pragma unroll
        for (int e = 0; e < 4; ++e) { const int kc = kc0 + 16 * t + 4 * fq + e; const bool valid = (kc >= cs) && (kc < cs + 16);
            w[e] = valid ? a->rpb[((size_t)(i * 16 + h) * 15 + (ii - v + 7)) * 31 + (kc - c + 15)] * 1.4426950408889634f : -1e30f; }
        *(f32x4*)(TB + (size_t)o * 4) = w;
    }
}

__device__ __forceinline__ void pool_phase(const bf16_t* ZP, bf16_t* CAT, int gw, int NGW, int lane) {
    const int gi = lane >> 4, w = 2 << gi, lo = w >> 1, hi = w - 1 - lo;
    for (int row = gw; row < MTOK; row += NGW) {
        const int tl = row & (SEQL - 1); float acc[8];
#pragma unroll
        for (int j = 0; j < 8; ++j) acc[j] = 0.f;
        const int d0 = -min(lo, tl), d1 = min(hi, SEQL - 1 - tl);
#pragma unroll
        for (int d = -8; d <= 7; ++d) if (d >= d0 && d <= d1) { const u32x4 z = *(const u32x4*)(ZP + (size_t)(row + d) * 512 + lane * 8);
            acc[0] += bf_lo(z.x); acc[1] += bf_hi(z.x); acc[2] += bf_lo(z.y); acc[3] += bf_hi(z.y); acc[4] += bf_lo(z.z); acc[5] += bf_hi(z.z); acc[6] += bf_lo(z.w); acc[7] += bf_hi(z.w); }
        const float inv = 1.0f / (float)(d1 - d0 + 1); const u32x4 z = *(const u32x4*)(ZP + (size_t)row * 512 + lane * 8);
        u32x4 o; o.x = cvt_pk_bf16(acc[0] * inv - bf_lo(z.x), acc[1] * inv - bf_hi(z.x)); o.y = cvt_pk_bf16(acc[2] * inv - bf_lo(z.y), acc[3] * inv - bf_hi(z.y));
        o.z = cvt_pk_bf16(acc[4] * inv - bf_lo(z.z), acc[5] * inv - bf_hi(z.z)); o.w = cvt_pk_bf16(acc[6] * inv - bf_lo(z.w), acc[7] * inv - bf_hi(z.w));
        *(u32x4*)(CAT + (size_t)row * 1024 + lane * 8) = o;
    }
}

__device__ __forceinline__ void carry_phase(ArgsP a, int i, int wave, int lane, int G) {
    const float* __restrict__ SL = (const float*)(a->ws + WS_SLOC); bf16_t* __restrict__ ZS = (bf16_t*)(a->ws + WS_ZS); const float2* LP = (const float2*)(a->ws + WS_LAMPOW);
    for (int item = wave * G + (int)blockIdx.x; item < 512; item += NWAV * G) {
        const int dir = item & 1, b = (item >> 1) & 7, g = item >> 4, q = (i * 2 + dir) * 32 + g, p = lane;
        const float2 lt = LP[(size_t)(q * 33 + 32) * 64 + p]; float cr = 0.f, ci = 0.f;
        const size_t rbase = (size_t)g * NCHUNK + b * 256;
        for (int c0 = 0; c0 < 256; c0 += 16) {
            float sr[16], si[16];
#pragma unroll
            for (int k = 0; k < 16; ++k) { const int c = dir == 0 ? c0 + k : 255 - (c0 + k); const size_t row = rbase + c; sr[k] = SL[row * 256 + dir * 128 + p]; si[k] = SL[row * 256 + dir * 128 + 64 + p]; }
#pragma unroll
            for (int k = 0; k < 16; ++k) { const int c = dir == 0 ? c0 + k : 255 - (c0 + k); const size_t row = rbase + c;
                bf16_t* z = ZS + row * 768 + 512 + dir * 128 + p;
                z[0] = (bf16_t)(cvt_pk_bf16(cr, cr) & 0xffffu); z[64] = (bf16_t)(cvt_pk_bf16(ci, ci) & 0xffffu);
                const float nr = lt.x * cr - lt.y * ci + sr[k], ni = lt.x * ci + lt.y * cr + si[k]; cr = nr; ci = ni; }
        }
    }
}

__device__ __forceinline__ void attn_phase(LAS unsigned char* lds, const bf16_t* QKV, const float* TBL  , bf16_t* O, int tid, int wave, int lane, int G) {
    LAS unsigned char* vt = lds + wave * 9216;
    const unsigned vt_addr = (unsigned)(uintptr_t)vt;
    const int fr = lane & 15, fq = lane >> 4;
    for (int it = (int)blockIdx.x * NWAV + wave; it < 65536; it += G * NWAV) {
        const int qt = it & 3, h = (it >> 2) & 15, r = (it >> 6) & 127, b = it >> 13;
        const int r0 = min(max(r - 4, 0), 120), kc0 = qt == 0 ? 0 : (qt == 1 ? 8 : (qt == 2 ? 24 : 32));
        const int c = 16 * qt + fr;
        const size_t tokq = (size_t)b * SEQL + r * 64 + c;
        const float* tb = TBL + ((size_t)(((r - r0) * 16 + h) * 4 + qt) * 16) * 256 + lane * 4;
        bf16x8 qf[2];
        const bf16_t* qh = QKV + ((size_t)(b * 16 + h) * SEQL) * 64; const bf16_t* kh = qh + (size_t)MTOK * DM; const bf16_t* vh = kh + (size_t)MTOK * DM;
        {
            const bf16_t* qsrc = qh + (size_t)(r * 64 + 16 * qt + (lane >> 3)) * 64 + (lane & 7) * 8;
            const u32x4 q0 = *(const u32x4*)qsrc, q1 = *(const u32x4*)(qsrc + (size_t)8 * 64);
            *(LAS u32x4*)(vt + (lane >> 3) * 144 + (lane & 7) * 16) = q0; *(LAS u32x4*)(vt + ((lane >> 3) + 8) * 144 + (lane & 7) * 16) = q1;
            qf[0] = *(const LAS bf16x8*)(vt + fr * 144 + 16 * fq); qf[1] = *(const LAS bf16x8*)(vt + fr * 144 + 64 + 16 * fq);
            asm volatile("s_waitcnt lgkmcnt(0)" ::: "memory"); }
        const int vkey = lane >> 3, vch = lane & 7;
        const bf16_t* vsrc = vh + (size_t)(r0 * 64 + kc0 + vkey) * 64 + vch * 8;
        u32x4 vr[4][2][4];
        f32x4 s[8][2]; u32x4 kr[4][2][4];
        const bf16_t* ksrc = kh + (size_t)(r0 * 64 + kc0 + vkey) * 64 + vch * 8;
#pragma unroll
        for (int i = 0; i < 8; ++i) { const bf16_t* src = ksrc + (size_t)i * 64 * 64;
#pragma unroll
            for (int j = 0; j < 4; ++j) kr[i >> 1][i & 1][j] = *(const u32x4*)(src + (size_t)j * 8 * 64); }
#pragma unroll
        for (int i = 0; i < 8; ++i)
#pragma unroll
            for (int t = 0; t < 2; ++t) s[i][t] = i < 4 ? *(const f32x4*)(tb + (i * 2 + t) * 256) : (f32x4){0.f, 0.f, 0.f, 0.f};
        __builtin_amdgcn_sched_barrier(0);
        f32x4 tb2[4][2];
#pragma unroll
        for (int ip = 0; ip < 4; ++ip) {
#pragma unroll
            for (int rr = 0; rr < 2; ++rr) { LAS unsigned char* dst = vt + rr * 4608 + vkey * 144 + vch * 16;
#pragma unroll
                for (int j = 0; j < 4; ++j) *(LAS u32x4*)(dst + j * 8 * 144) = kr[ip][rr][j]; }
            if (ip == 1) {
#pragma unroll
                for (int i = 0; i < 4; ++i)
#pragma unroll
                    for (int t = 0; t < 2; ++t) tb2[i][t] = *(const f32x4*)(tb + ((i + 4) * 2 + t) * 256); }
#pragma unroll
            for (int rr = 0; rr < 2; ++rr)
#pragma unroll
                for (int t = 0; t < 2; ++t) { const LAS unsigned char* kp = vt + rr * 4608 + (16 * t + fr) * 144 + 16 * fq;
                    const bf16x8 k0 = *(const LAS bf16x8*)kp, k1 = *(const LAS bf16x8*)(kp + 64);
                    s[2 * ip + rr][t] = __builtin_amdgcn_mfma_f32_16x16x32_bf16(k0, qf[0], s[2 * ip + rr][t], 0, 0, 0); s[2 * ip + rr][t] = __builtin_amdgcn_mfma_f32_16x16x32_bf16(k1, qf[1], s[2 * ip + rr][t], 0, 0, 0); }
            asm volatile("s_waitcnt lgkmcnt(0)" ::: "memory");
        }
#pragma unroll
        for (int i = 0; i < 4; ++i)
#pragma unroll
            for (int t = 0; t < 2; ++t) s[i + 4][t] = s[i + 4][t] + tb2[i][t];
        __builtin_amdgcn_sched_barrier(0);
#pragma unroll
        for (int i = 0; i < 8; ++i) { const bf16_t* src = vsrc + (size_t)i * 64 * 64;
#pragma unroll
            for (int j = 0; j < 4; ++j) vr[i >> 1][i & 1][j] = *(const u32x4*)(src + (size_t)j * 8 * 64); }
        __builtin_amdgcn_sched_barrier(0);
        float mx = -1e30f;
#pragma unroll
        for (int i = 0; i < 8; ++i)
#pragma unroll
            for (int t = 0; t < 2; ++t) mx = fmaxf(fmaxf(mx, fmaxf(s[i][t][0], s[i][t][1])), fmaxf(s[i][t][2], s[i][t][3]));
        mx = fmaxf(mx, __shfl_xor(mx, 16)); mx = fmaxf(mx, __shfl_xor(mx, 32));
        float sum = 0.f;
#pragma unroll
        for (int i = 0; i < 8; ++i)
#pragma unroll
            for (int t = 0; t < 2; ++t)
#pragma unroll
                for (int e = 0; e < 4; ++e) { const float pe = __builtin_amdgcn_exp2f(s[i][t][e] - mx); s[i][t][e] = pe; sum += pe; }
        sum += __shfl_xor(sum, 16); sum += __shfl_xor(sum, 32);
        f32x4 o[4];
#pragma unroll
        for (int dt = 0; dt < 4; ++dt) o[dt] = (f32x4){0.f, 0.f, 0.f, 0.f};
        const unsigned ad = vt_addr + (unsigned)((4 * fq + (fr >> 2)) * 144 + 8 * (fr & 3));
#pragma unroll
        for (int ip = 0; ip < 4; ++ip) {
#pragma unroll
            for (int rr = 0; rr < 2; ++rr) { LAS unsigned char* dst = vt + rr * 4608 + vkey * 144 + vch * 16;
#pragma unroll
                for (int j = 0; j < 4; ++j) *(LAS u32x4*)(dst + j * 8 * 144) = vr[ip][rr][j]; }
            union { u32x4 w; bf16x8 v; } pf0, pf1; pf0.w = pack8(s[2 * ip][0], s[2 * ip][1]); pf1.w = pack8(s[2 * ip + 1][0], s[2 * ip + 1][1]);
            s16x4 ta0, ta1, ta2, ta3, tb0, tb1, tb2, tb3, ua0, ua1, ua2, ua3, ub0, ub1, ub2, ub3;
            asm volatile("ds_read_b64_tr_b16 %0, %16\n\tds_read_b64_tr_b16 %1, %16 offset:32\n\tds_read_b64_tr_b16 %2, %16 offset:64\n\tds_read_b64_tr_b16 %3, %16 offset:96\n\t"
                         "ds_read_b64_tr_b16 %4, %16 offset:2304\n\tds_read_b64_tr_b16 %5, %16 offset:2336\n\tds_read_b64_tr_b16 %6, %16 offset:2368\n\tds_read_b64_tr_b16 %7, %16 offset:2400\n\t"
                         "ds_read_b64_tr_b16 %8, %16 offset:4608\n\tds_read_b64_tr_b16 %9, %16 offset:4640\n\tds_read_b64_tr_b16 %10, %16 offset:4672\n\tds_read_b64_tr_b16 %11, %16 offset:4704\n\t"
                         "ds_read_b64_tr_b16 %12, %16 offset:6912\n\tds_read_b64_tr_b16 %13, %16 offset:6944\n\tds_read_b64_tr_b16 %14, %16 offset:6976\n\tds_read_b64_tr_b16 %15, %16 offset:7008\n\ts_waitcnt lgkmcnt(0)"
                         : "=&v"(ta0), "=&v"(ta1), "=&v"(ta2), "=&v"(ta3), "=&v"(tb0), "=&v"(tb1), "=&v"(tb2), "=&v"(tb3), "=&v"(ua0), "=&v"(ua1), "=&v"(ua2), "=&v"(ua3), "=&v"(ub0), "=&v"(ub1), "=&v"(ub2), "=&v"(ub3) : "v"(ad) : "memory");
            bf16x8 vf;
            vf = (bf16x8){ta0[0], ta0[1], ta0[2], ta0[3], tb0[0], tb0[1], tb0[2], tb0[3]}; o[0] = __builtin_amdgcn_mfma_f32_16x16x32_bf16(vf, pf0.v, o[0], 0, 0, 0);
            vf = (bf16x8){ta1[0], ta1[1], ta1[2], ta1[3], tb1[0], tb1[1], tb1[2], tb1[3]}; o[1] = __builtin_amdgcn_mfma_f32_16x16x32_bf16(vf, pf0.v, o[1], 0, 0, 0);
            vf = (bf16x8){ta2[0], ta2[1], ta2[2], ta2[3], tb2[0], tb2[1], tb2[2], tb2[3]}; o[2] = __builtin_amdgcn_mfma_f32_16x16x32_bf16(vf, pf0.v, o[2], 0, 0, 0);
            vf = (bf16x8){ta3[0], ta3[1], ta3[2], ta3[3], tb3[0], tb3[1], tb3[2], tb3[3]}; o[3] = __builtin_amdgcn_mfma_f32_16x16x32_bf16(vf, pf0.v, o[3], 0, 0, 0);
            vf = (bf16x8){ua0[0], ua0[1], ua0[2], ua0[3], ub0[0], ub0[1], ub0[2], ub0[3]}; o[0] = __builtin_amdgcn_mfma_f32_16x16x32_bf16(vf, pf1.v, o[0], 0, 0, 0);
            vf = (bf16x8){ua1[0], ua1[1], ua1[2], ua1[3], ub1[0], ub1[1], ub1[2], ub1[3]}; o[1] = __builtin_amdgcn_mfma_f32_16x16x32_bf16(vf, pf1.v, o[1], 0, 0, 0);
            vf = (bf16x8){ua2[0], ua2[1], ua2[2], ua2[3], ub2[0], ub2[1], ub2[2], ub2[3]}; o[2] = __builtin_amdgcn_mfma_f32_16x16x32_bf16(vf, pf1.v, o[2], 0, 0, 0);
            vf = (bf16x8){ua3[0], ua3[1], ua3[2], ua3[3], ub3[0], ub3[1], ub3[2], ub3[3]}; o[3] = __builtin_amdgcn_mfma_f32_16x16x32_bf16(vf, pf1.v, o[3], 0, 0, 0);
        }
        const float inv = 1.0f / sum;
#pragma unroll
        for (int dt = 0; dt < 4; ++dt) { u32x2 w; w.x = cvt_pk_bf16(o[dt][0] * inv, o[dt][1] * inv); w.y = cvt_pk_bf16(o[dt][2] * inv, o[dt][3] * inv);
            *(LAS u32x2*)(vt + fr * 144 + (16 * dt + 4 * fq) * 2) = w; }
        { const u32x4 o0 = *(const LAS u32x4*)(vt + (lane >> 3) * 144 + (lane & 7) * 16), o1 = *(const LAS u32x4*)(vt + ((lane >> 3) + 8) * 144 + (lane & 7) * 16);
          bf16_t* od = O + ((size_t)b * SEQL + r * 64 + 16 * qt + (lane >> 3)) * 1024 + h * 64 + (lane & 7) * 8;
          *(u32x4*)od = o0; *(u32x4*)(od + (size_t)8 * 1024) = o1;
          asm volatile("s_waitcnt lgkmcnt(0)" ::: "memory"); }
    }
}
#ifndef EN_SETUP
#define EN_SETUP 1
#endif
#ifndef EN_EVEN
#define EN_EVEN 1
#endif
#ifndef EN_ODD
#define EN_ODD 1
#endif
#ifndef EN_ATT
#define EN_ATT 1
#endif
#ifndef DUP_ROW
#define DUP_ROW 1
#endif
#ifndef DUP_ATT
#define DUP_ATT 1
#endif
#ifndef DUP_PC
#define DUP_PC 1
#endif
#ifndef DUP_FFN
#define DUP_FFN 1
#endif
#ifndef DUP_MIX
#define DUP_MIX 1
#endif
#ifndef DUP_P0
#define DUP_P0 1
#endif
#define GEMM_SP2 true
#define GEMM_ALIGN true
__global__ void __launch_bounds__(NTHR, 2) fwd_megakernel(Args kargs) {
    extern __shared__ __attribute__((aligned(16))) unsigned char lds_raw[];
    LAS unsigned char* lds = (LAS unsigned char*)lds_raw;
    cg::grid_group grid = cg::this_grid();
    const int G = gridDim.x, bx = blockIdx.x, NGW = G * NWAV, NGT = G * NTHR;
    const int lo = kargs.ph_lo, hi = kargs.ph_hi; int ph = 0;
    volatile LAS unsigned* xst = (volatile LAS unsigned*)(lds + 131072 + 8128);
    if (threadIdx.x < 2) xst[threadIdx.x] = 0u;
    __syncthreads();
    const XcdBarrier xbar = xcd_barrier_post((unsigned*)(kargs.ws + WS_BAR), xst);
#define PH_BEGIN if (ph >= lo && ph < hi) { ArgsP a = args_ptr(); int tid = threadIdx.x; asm volatile("" : "+v"(tid)); const int lane = tid & 63, wave = __builtin_amdgcn_readfirstlane(tid >> 6), gw = bx * NWAV + wave, gt = bx * NTHR + tid; \
    unsigned char* ws = a->ws; bf16_t* HB = (bf16_t*)(ws + WS_XN); bf16_t* SCR = (bf16_t*)a->out; float* RS = (float*)(ws + WS_RS); bf16_t* FB = (bf16_t*)(ws + WS_F); bf16_t* BIG = (bf16_t*)(ws + WS_BIG); bf16_t* ZS = (bf16_t*)(ws + WS_ZS); float* SLOC = (float*)(ws + WS_SLOC); bf16_t* YG = (bf16_t*)(ws + WS_YG); \
    (void)lane; (void)wave; (void)gw; (void)gt; (void)HB; (void)SCR; (void)RS; (void)FB; (void)BIG; (void)ZS; (void)SLOC; (void)YG;
#ifndef DUP_SYNC
#define DUP_SYNC 1
#endif
#define PH_END } { const bool seam = (ph >= lo && ph + 1 < hi); ++ph; if (seam) for (int rs = 0; rs < DUP_SYNC; ++rs) { if (ph == 2) grid.sync(); else xcd_barrier(xbar); } }

    PH_BEGIN
        ssm_tables0(a, gt, NGT);
    PH_END
    PH_BEGIN
      for (int rep = 0; rep < DUP_P0; ++rep) {
#if EN_SETUP
        ssm_tables1(a, gt, NGT);
        attn_table(a, gt, NGT);
        wcat_fold(a, gt, NGT);
        transposes_phase(a, (LAS float*)(lds + wave * 8448), gw, NGW, lane);
#endif
        rowwise_phase(a->x, HB, nullptr, nullptr, 0.f, RS, nullptr, gw, NGW, lane);
      }
    PH_END

#pragma nounroll
    for (int layer = 0; layer < 4; ++layer) {
        const int mi = layer >> 1;
#pragma nounroll
        for (int half = 0; half < 2; ++half) {
            if (half == 1) {
                if ((layer & 1) == 0) {
#if EN_EVEN
                    PH_BEGIN
                        pg8::Gemm g{HB, (const bf16_t*)(ws + WS_WIN) + (size_t)mi * DM * DM, MTOK, DM, DM, DM, DM, 0, 0}; pg8::StaticOrder S; S.init(MTOK, DM, G, bx);
                        LAS float* rsl = (LAS float*)(lds + 131072); rsl_fill(rsl, RS, bx, tid);
                        EpiZ E{FB, ZS, rsl};
                        for (int rep = 0; rep < DUP_MIX; ++rep) { pg8::gemm_phase<EpiZ, pg8::StaticOrder, GEMM_ALIGN, GEMM_SP2>(lds, g, S, E); }
                    PH_END
                    PH_BEGIN
                        for (int rep = 0; rep < DUP_PC; ++rep) pool_phase(FB, SCR, gw, NGW, lane);
                        pg8::Gemm g{ZS, (const bf16_t*)(ws + WS_WST + (size_t)mi * 32 * SZ_WST), NCHUNK, 256, 512, 768, 512, (size_t)NCHUNK * 768 * 2, SZ_WST}; BatchOrder S; S.init(NCHUNK, 256, 32, G, bx);
                        EpiState E{SLOC};
                        for (int rep = 0; rep < DUP_MIX; ++rep) { pg8::gemm_phase<EpiState, BatchOrder, GEMM_ALIGN, GEMM_SP2>(lds, g, S, E); }
                    PH_END
                    PH_BEGIN
                        for (int rep = 0; rep < DUP_PC; ++rep) { carry_phase(a, mi, wave, lane, G); }
                        if (layer == 0) ssm_tables2(a, gt, NGT);
                    PH_END
                    PH_BEGIN
                        pg8::Gemm g{ZS, (const bf16_t*)(ws + WS_MTOEP + (size_t)mi * 32 * SZ_MTOEP), NCHUNK, 512, 768, 768, 768, (size_t)NCHUNK * 768 * 2, SZ_MTOEP}; BatchOrder S; S.init(NCHUNK, 512, 32, G, bx);
                        EpiSsmOut E{YG};
                        for (int rep = 0; rep < DUP_MIX; ++rep) { pg8::gemm_phase<EpiSsmOut, BatchOrder, GEMM_ALIGN, GEMM_SP2>(lds, g, S, E); }
                    PH_END
                    PH_BEGIN
                        pg8::Gemm g{YG, (const bf16_t*)(ws + WS_WGLU) + (size_t)mi * 512 * 512, MTOK, 512, 512, 512, 512, 0, 0}; pg8::StaticOrder S; S.init(MTOK, 512, G, bx);
                        EpiGlu E{YG, a->b_glu + mi * 512, SCR};
                        for (int rep = 0; rep < DUP_MIX; ++rep) { pg8::gemm_phase<EpiGlu, pg8::StaticOrder, GEMM_ALIGN, GEMM_SP2>(lds, g, S, E); }
                    PH_END
                    PH_BEGIN
                        pg8::Gemm g{SCR, (const bf16_t*)(ws + WS_WCAT) + (size_t)mi * DM * DM, MTOK, DM, DM, DM, DM, 0, 0};
                        pg8::StaticOrder S; S.init(MTOK, DM, G, bx);
                        EpiResNorm E{HB, a->norm_g + (size_t)layer * 6 * DM + 3 * DM, 1.0f, (float*)(ws + WS_XS), RS, (unsigned*)(ws + WS_PCNT), 4u * (unsigned)(3 * layer + 2), nullptr, lds + 131072};
                        pg8::gemm_phase<EpiResNorm, pg8::StaticOrder, true, GEMM_SP2>(lds, g, S, E);
                    PH_END
#endif
                } else {
#if EN_ODD
                    PH_BEGIN
                        pg8::Gemm g{HB, (const bf16_t*)(ws + WS_WQKV) + (size_t)mi * 3072 * DM, MTOK, 3072, DM, DM, DM, 0, 0}; pg8::StaticOrder S; S.init(MTOK, 3072, G, bx);
                        LAS float* rsl = (LAS float*)(lds + 131072); rsl_fill(rsl, RS, bx, tid);
                        EpiQKV E{BIG, rsl};
                        for (int rep = 0; rep < DUP_MIX; ++rep) { pg8::gemm_phase<EpiQKV, pg8::StaticOrder, GEMM_ALIGN, GEMM_SP2>(lds, g, S, E); }
                    PH_END
                    PH_BEGIN
#if EN_ATT
                        for (int rep = 0; rep < DUP_ATT; ++rep) { attn_phase(lds, BIG, (const float*)(ws + WS_ATB) + (size_t)mi * 2097152, SCR, tid, wave, lane, G); }
#endif
                        __syncthreads();
                    PH_END
                    PH_BEGIN
                        pg8::Gemm g{SCR, (const bf16_t*)(ws + WS_WO) + (size_t)mi * DM * DM, MTOK, DM, DM, DM, DM, 0, 0};
                        pg8::StaticOrder S; S.init(MTOK, DM, G, bx);
                        EpiResNorm E{HB, a->norm_g + (size_t)layer * 6 * DM + 3 * DM, 1.0f, (float*)(ws + WS_XS), RS, (unsigned*)(ws + WS_PCNT), 4u * (unsigned)(3 * layer + 2), nullptr, lds + 131072};
                        pg8::gemm_phase<EpiResNorm, pg8::StaticOrder, true, GEMM_SP2>(lds, g, S, E);
                    PH_END
#endif
                }
            }
            const int f = layer * 2 + half;
            PH_BEGIN
                pg8::Gemm g{HB, (const bf16_t*)(ws + WS_WGU + (size_t)f * SZ_WGU), MTOK, 2 * DFF, DM, DM, DM, 0, 0}; pg8::StaticOrder S; S.init(MTOK, 2 * DFF, G, bx);
                LAS float* rsl = (LAS float*)(lds + 131072);
                { const int nwg = 256 * 22, q8 = nwg / 8, wg0 = (bx % 8) * q8 + bx / 8, off = (wg0 % 176) % 8;
#pragma unroll
                  for (int k = 0; k < 4; ++k) { const int pmk = 8 * ((bx % 8) * 4 + k) + off; if (tid < 256) rsl[k * 256 + tid] = row_rs(RS, pmk * 256 + tid); } }
                __syncthreads();
                EpiSwiglu E{BIG, rsl};
                for (int rep = 0; rep < DUP_FFN; ++rep) pg8::gemm_phase<EpiSwiglu, pg8::StaticOrder, GEMM_ALIGN, GEMM_SP2>(lds, g, S, E);
            PH_END
            PH_BEGIN
                pg8::Gemm g{BIG, (const bf16_t*)(ws + WS_WD + (size_t)f * SZ_WD), MTOK, DM, DFF, DFF, DFF, 0, 0};
                pg8::StaticOrder S; S.init(MTOK, DM, G, bx);
                EpiResNorm E{HB, a->norm_g + (size_t)layer * 6 * DM + (half == 0 ? 1 : 5) * DM, 0.5f, (float*)(ws + WS_XS), RS, (unsigned*)(ws + WS_PCNT), 4u * (unsigned)(3 * layer + (half == 0 ? 1 : 3)), (layer == 3 && half == 1) ? a->out : nullptr, lds + 131072};
                pg8::gemm_phase<EpiResNorm, pg8::StaticOrder, true, GEMM_SP2>(lds, g, S, E);
            PH_END
        }
    }
}

extern "C" void kernel_launch(void* const* d_in, const int* in_sizes, int n_in, void* d_out, int out_size, void* d_ws, size_t ws_size, hipStream_t stream) {
    static int grid = 0;
    if (grid == 0) {
        if (n_in != 22 || out_size != MTOK * DM || ws_size < WS_END) { fprintf(stderr, "kernel_launch: unexpected problem (n_in %d, out %d, ws %zu, need %zu)\n", n_in, out_size, ws_size, (size_t)WS_END); grid = -1; return; }
        int dev = 0, cus = 0, per_cu = 0;
        hipGetDevice(&dev); hipDeviceGetAttribute(&cus, hipDeviceAttributeMultiprocessorCount, dev);
        if (hipFuncSetAttribute((const void*)fwd_megakernel, hipFuncAttributeMaxDynamicSharedMemorySize, LDS_BYTES) != hipSuccess) { fprintf(stderr, "kernel_launch: hipFuncSetAttribute failed\n"); }
        if (hipOccupancyMaxActiveBlocksPerMultiprocessor(&per_cu, (const void*)fwd_megakernel, NTHR, LDS_BYTES) != hipSuccess || per_cu < 1) { fprintf(stderr, "kernel_launch: occupancy query says %d blocks/CU; using 1\n", per_cu); per_cu = 1; }
        (void)hipGetLastError();
        grid = cus * 1;
        if (per_cu < 1) grid = -1;
    }
    if (grid < 0) return;
    Args a{};
    a.x = (const float*)d_in[0]; a.norm_g = (const float*)d_in[1]; a.w_gate = (const float*)d_in[2]; a.w_up = (const float*)d_in[3]; a.w_down = (const float*)d_in[4];
    a.ab_w_in = (const float*)d_in[5]; a.pool_w = (const float*)d_in[6]; a.pool_scale = (const float*)d_in[7]; a.A_re = (const float*)d_in[8]; a.A_im = (const float*)d_in[9];
    a.log_dt = (const float*)d_in[10]; a.B_re = (const float*)d_in[11]; a.B_im = (const float*)d_in[12]; a.C_re = (const float*)d_in[13]; a.C_im = (const float*)d_in[14];
    a.ssm_D = (const float*)d_in[15]; a.w_glu = (const float*)d_in[16]; a.b_glu = (const float*)d_in[17]; a.ab_w_out = (const float*)d_in[18]; a.w_qkv = (const float*)d_in[19];
    a.rpb = (const float*)d_in[20]; a.na_w_out = (const float*)d_in[21];
    a.out = (float*)d_out; a.ws = (unsigned char*)d_ws; a.ph_lo = 0; a.ph_hi = 1 << 20;
    if (hipMemsetAsync((unsigned char*)d_ws + WS_BAR, 0, BAR_BYTES, stream) != hipSuccess) { fprintf(stderr, "kernel_launch: memset of barrier words failed\n"); return; }
    void* args[] = {&a};
    hipError_t e = hipLaunchCooperativeKernel((const void*)fwd_megakernel, dim3(grid), dim3(NTHR), args, LDS_BYTES, stream);
    if (e != hipSuccess) fprintf(stderr, "kernel_launch: cooperative launch failed: %s (grid %d)\n", hipGetErrorString(e), grid);
}
```

```cpp
#include <hip/hip_runtime.h>
#include <hip/hip_cooperative_groups.h>
#include <cstdio>
#include <cstdint>
namespace cg = cooperative_groups;
namespace pg8 {
#define PG8_LAS __attribute__((address_space(3)))
typedef unsigned short bf16_t;
typedef short bf16x8 __attribute__((ext_vector_type(8)));
typedef float f32x4 __attribute__((ext_vector_type(4)));
typedef unsigned u32x4 __attribute__((ext_vector_type(4)));
constexpr int BM = 256, BK = 64, HALF = 128, HTB = HALF * BK * 2  , STAGE_BYTES = 8 * HTB, NXCD = 8, WGM = 8;

__host__ __device__ __forceinline__ int lds_byte(int r, int c) { const int st = (r >> 4) * 2 + (c >> 5), rr = r & 15, cc = c & 31, ob = rr * 64 + cc * 2; return st * 1024 + (ob ^ (((ob >> 9) & 1) << 5)); }
__host__ __device__ __forceinline__ void stage_rc(int b, int& R, int& C) { const int st = b / 1024, sb = b % 1024, swz = sb ^ (((sb >> 9) & 1) << 5); R = (st >> 1) * 16 + swz / 64; C = (st & 1) * 32 + (swz % 64) / 2; }
__host__ __device__ __forceinline__ int perm32(int rho) { const int n = rho >> 4, i = rho & 15; return 8 * (i >> 2) + 4 * n + (i & 3); }

struct Unit { int pm, pn, pb; };
struct Gemm { const bf16_t* A; const bf16_t* Bt; int M, N, K, lda, ldb; size_t sA, sB; };

struct StaticOrder {
    int nM, nN, nwg, G, c;
    __host__ __device__ void init(int M, int N, int G_, int c_) { nM = M / BM; nN = N / BM; nwg = nM * nN; G = G_; c = c_; }
    __host__ __device__ bool next(int i, Unit& u) const {
        const long L = (long)i * G + c; if (L >= nwg) return false;
        int wgid = (int)L; { const int q = nwg / NXCD, r = nwg % NXCD, xcd = wgid % NXCD, off = wgid / NXCD; wgid = (xcd < r ? xcd * (q + 1) : r * (q + 1) + (xcd - r) * q) + off; }
        const int nig = WGM * nN, gid = wgid / nig, fm = gid * WGM, gsz = (nM - fm) < WGM ? (nM - fm) : WGM;
        u.pm = fm + ((wgid % nig) % gsz); u.pn = (wgid % nig) / gsz; u.pb = 0; return true;
    }
    __device__ __forceinline__ void a_ready(const Unit&) const {}
    __device__ __forceinline__ void done(const Unit&) const {}
};


template <class Epi, class Sched, bool ALIGN_EPI = false, bool SP2 = false>
__device__ __forceinline__ void gemm_phase(PG8_LAS unsigned char* lds, const Gemm g, const Sched& S, const Epi& E) {
    int tid_ = threadIdx.x; asm volatile("" : "+v"(tid_));
    const int tid = tid_, wid = __builtin_amdgcn_readfirstlane(tid >> 6), lane = tid & 63, wr = wid >> 2, wc = wid & 3, fr = lane & 15, fq = lane >> 4;
    const int K = g.K, nt = K / BK;
    unsigned voffA[2], voffB[2];
#pragma unroll
    for (int i = 0; i < 2; ++i) { int R, C; stage_rc(tid * 16 + i * 8192, R, C); const int Rb = Epi::PERM ? ((R & ~31) + perm32(R & 31)) : R;
        voffA[i] = (unsigned)(R * g.lda + C) * 2u; voffB[i] = (unsigned)(Rb * g.ldb + C) * 2u; }
    const size_t kstep = (size_t)(BK * 2);
    const size_t hstepA = (size_t)HALF * g.lda * 2, hstepB = (size_t)HALF * g.ldb * 2;
    const size_t tstepA = 2 * hstepA, tstepB = 2 * hstepB;
    const unsigned ldsw = (unsigned)wid * 1024u;
    const int aoff = lds_byte(wr * 64 + fr, fq * 8), boff = lds_byte(wc * 32 + fr, fq * 8);
#define PG8_SA(b, h) (((b) * 2 + (h)) * HTB)
#define PG8_SB(b, h) ((4 + (b) * 2 + (h)) * HTB)
#define PG8_STAGE(bufoff, gbase, voff) do { _Pragma("unroll") for (int _i = 0; _i < 2; ++_i) \
        __builtin_amdgcn_global_load_lds((const unsigned*)((const char*)(gbase) + (voff)[_i]), (PG8_LAS unsigned*)(lds + (bufoff) + ldsw + _i * 8192), 16, 0, 0); } while (0)
#define PG8_LDA(dst, b, h) do { _Pragma("unroll") for (int m = 0; m < 4; ++m) _Pragma("unroll") for (int k = 0; k < 2; ++k) dst[m][k] = *(const PG8_LAS bf16x8*)(lds + PG8_SA(b, h) + aoff + m * 2048 + k * 1024); } while (0)
#define PG8_LDB(dst, b, h) do { _Pragma("unroll") for (int n = 0; n < 2; ++n) _Pragma("unroll") for (int k = 0; k < 2; ++k) dst[n][k] = *(const PG8_LAS bf16x8*)(lds + PG8_SB(b, h) + boff + n * 2048 + k * 1024); } while (0)
#define PG8_MMA(ai, bj, At, Bt) do { __builtin_amdgcn_s_setprio(1); _Pragma("unroll") for (int m = 0; m < 4; ++m) _Pragma("unroll") for (int n = 0; n < 2; ++n) _Pragma("unroll") for (int k = 0; k < 2; ++k) \
        acc[ai][bj][m][n] = __builtin_amdgcn_mfma_f32_16x16x32_bf16(Bt[n][k], At[m][k], acc[ai][bj][m][n], 0, 0, 0); __builtin_amdgcn_s_setprio(0); } while (0)
#define PG8_WAIT_V(n) asm volatile("s_waitcnt vmcnt(" #n ")" ::: "memory")
#define PG8_WAIT_L(n) asm volatile("s_waitcnt lgkmcnt(" #n ")" ::: "memory")
#define PG8_BAR __builtin_amdgcn_s_barrier()
#define PG8_SCHED __builtin_amdgcn_sched_barrier(0)
    Unit cur, nxt; int ui = 0;
    if (!S.next(0, cur)) return;
    f32x4 acc[2][2][4][2];
#pragma unroll
    for (int a = 0; a < 2; ++a)
#pragma unroll
        for (int b = 0; b < 2; ++b)
#pragma unroll
            for (int m = 0; m < 4; ++m)
#pragma unroll
                for (int n = 0; n < 2; ++n) acc[a][b][m][n] = (f32x4){0.f, 0.f, 0.f, 0.f};
    bf16x8 At[4][2], B0[2][2], B1[2][2];
    const char* cA = (const char*)g.A + (size_t)cur.pm * tstepA + (size_t)cur.pb * g.sA; const char* cB = (const char*)g.Bt + (size_t)cur.pn * tstepB + (size_t)cur.pb * g.sB;
    S.a_ready(cur);
    if constexpr (SP2) {
        PG8_STAGE(PG8_SB(0, 0), cB, voffB); PG8_STAGE(PG8_SB(0, 1), cB + hstepB, voffB); PG8_STAGE(PG8_SA(0, 0), cA, voffA); PG8_STAGE(PG8_SA(0, 1), cA + hstepA, voffA);
        if (wr == 1) PG8_BAR;
        PG8_WAIT_V(2); PG8_BAR;
        PG8_STAGE(PG8_SB(1, 0), cB + kstep, voffB); PG8_STAGE(PG8_SA(1, 0), cA + kstep, voffA); PG8_STAGE(PG8_SB(1, 1), cB + hstepB + kstep, voffB);
        PG8_WAIT_V(6); PG8_BAR;
    } else {
        PG8_STAGE(PG8_SB(0, 0), cB, voffB); PG8_STAGE(PG8_SA(0, 0), cA, voffA); PG8_STAGE(PG8_SB(0, 1), cB + hstepB, voffB); PG8_STAGE(PG8_SA(0, 1), cA + hstepA, voffA);
        if (wr == 1) PG8_BAR;
        PG8_WAIT_V(4); PG8_BAR;
        PG8_STAGE(PG8_SB(1, 0), cB + kstep, voffB); PG8_STAGE(PG8_SA(1, 0), cA + kstep, voffA); PG8_STAGE(PG8_SB(1, 1), cB + hstepB + kstep, voffB);
        PG8_WAIT_V(6); PG8_BAR;
    }
    for (;;) {
        const bool has_next = S.next(ui + 1, nxt);
        const char* nA = has_next ? (const char*)g.A + (size_t)nxt.pm * tstepA + (size_t)nxt.pb * g.sA : cA; const char* nB = has_next ? (const char*)g.Bt + (size_t)nxt.pn * tstepB + (size_t)nxt.pb * g.sB : cB;
        for (int t = 0; t < nt; t += 2) {
            const bool last = (t == nt - 2);
            const char* a1 = cA + (size_t)(t + 1) * kstep;
            const char* a2 = last ? nA : cA + (size_t)(t + 2) * kstep; const char* b2 = last ? nB : cB + (size_t)(t + 2) * kstep;
            const char* a3 = a2 + kstep; const char* b3 = b2 + kstep;
            if (last && has_next) S.a_ready(nxt);
            if constexpr (SP2) {
            PG8_LDB(B0, 0, 0); PG8_LDB(B1, 0, 1); PG8_SCHED; PG8_LDA(At, 0, 0); PG8_STAGE(PG8_SA(1, 1), a1 + hstepA, voffA);
            PG8_WAIT_V(8); PG8_WAIT_L(0); PG8_BAR; PG8_MMA(0, 0, At, B0); PG8_MMA(0, 1, At, B1); PG8_BAR; PG8_SCHED;
            PG8_LDA(At, 0, 1); PG8_STAGE(PG8_SB(0, 0), b2, voffB); PG8_STAGE(PG8_SB(0, 1), b2 + hstepB, voffB); PG8_STAGE(PG8_SA(0, 0), a2, voffA);
            PG8_WAIT_V(8); PG8_WAIT_L(0); PG8_BAR; PG8_MMA(1, 0, At, B0); PG8_MMA(1, 1, At, B1); PG8_BAR; PG8_SCHED;
            PG8_LDB(B0, 1, 0); PG8_LDB(B1, 1, 1); PG8_SCHED; PG8_LDA(At, 1, 0); PG8_STAGE(PG8_SA(0, 1), a2 + hstepA, voffA);
            PG8_WAIT_V(8); PG8_WAIT_L(0); PG8_BAR; PG8_MMA(0, 0, At, B0); PG8_MMA(0, 1, At, B1); PG8_BAR; PG8_SCHED;
            PG8_LDA(At, 1, 1); PG8_STAGE(PG8_SB(1, 0), b3, voffB); PG8_STAGE(PG8_SB(1, 1), b3 + hstepB, voffB); PG8_STAGE(PG8_SA(1, 0), a3, voffA);
            PG8_WAIT_V(8); PG8_WAIT_L(0); PG8_BAR; PG8_MMA(1, 0, At, B0); PG8_MMA(1, 1, At, B1); PG8_BAR; PG8_SCHED;
            } else {
            PG8_LDB(B0, 0, 0); PG8_SCHED; PG8_LDA(At, 0, 0); PG8_STAGE(PG8_SA(1, 1), a1 + hstepA, voffA);
            PG8_WAIT_L(8); PG8_BAR; PG8_WAIT_L(0); PG8_MMA(0, 0, At, B0); PG8_BAR; PG8_SCHED;
            PG8_LDB(B1, 0, 1); PG8_STAGE(PG8_SB(0, 0), b2, voffB);
            PG8_BAR; PG8_WAIT_L(0); PG8_MMA(0, 1, At, B1); PG8_BAR;
            PG8_LDA(At, 0, 1); PG8_STAGE(PG8_SA(0, 0), a2, voffA);
            PG8_BAR; PG8_WAIT_L(0); PG8_MMA(1, 0, At, B0); PG8_BAR; PG8_SCHED;
            PG8_STAGE(PG8_SB(0, 1), b2 + hstepB, voffB);
            PG8_WAIT_V(6); PG8_BAR; PG8_MMA(1, 1, At, B1); PG8_BAR;
            PG8_LDB(B0, 1, 0); PG8_SCHED; PG8_LDA(At, 1, 0); PG8_STAGE(PG8_SA(0, 1), a2 + hstepA, voffA);
            PG8_WAIT_L(8); PG8_BAR; PG8_WAIT_L(0); PG8_MMA(0, 0, At, B0); PG8_BAR; PG8_SCHED;
            PG8_LDB(B1, 1, 1); PG8_STAGE(PG8_SB(1, 0), b3, voffB);
            PG8_BAR; PG8_WAIT_L(0); PG8_MMA(0, 1, At, B1); PG8_BAR;
            PG8_LDA(At, 1, 1); PG8_STAGE(PG8_SA(1, 0), a3, voffA);
            PG8_BAR; PG8_WAIT_L(0); PG8_MMA(1, 0, At, B0); PG8_BAR; PG8_SCHED;
            PG8_STAGE(PG8_SB(1, 1), b3 + hstepB, voffB);
            PG8_WAIT_V(6); PG8_BAR; PG8_MMA(1, 1, At, B1); PG8_BAR;
            }
        }
        if constexpr (ALIGN_EPI) { if (wr == 0) PG8_BAR; }
        if constexpr (!Epi::AFTER_DRAIN) { E(acc, cur, wr, wc, fr, fq); S.done(cur); }
        if (!has_next) break;
#pragma unroll
        for (int a = 0; a < 2; ++a)
#pragma unroll
            for (int b = 0; b < 2; ++b)
#pragma unroll
                for (int m = 0; m < 4; ++m)
#pragma unroll
                    for (int n = 0; n < 2; ++n) acc[a][b][m][n] = (f32x4){0.f, 0.f, 0.f, 0.f};
        cur = nxt; cA = nA; cB = nB; ++ui;
        if constexpr (ALIGN_EPI) { if (wr == 1) PG8_BAR; }
    }
    PG8_WAIT_V(0);
    if constexpr (!ALIGN_EPI) { if (wr == 0) PG8_BAR; }
    PG8_BAR;
    if constexpr (Epi::AFTER_DRAIN) { E.fused(acc, cur, wr, wc, fr, fq, lds, wid, lane); S.done(cur); }
#undef PG8_SA
#undef PG8_SB
#undef PG8_STAGE
#undef PG8_LDA
#undef PG8_LDB
#undef PG8_MMA
#undef PG8_WAIT_V
#undef PG8_WAIT_L
#undef PG8_BAR
#undef PG8_SCHED
}
}
using pg8::bf16_t; using pg8::bf16x8; using pg8::f32x4; using pg8::u32x4; using pg8::Unit;
#define LAS PG8_LAS
typedef unsigned u32x2 __attribute__((ext_vector_type(2)));
typedef short s16x4 __attribute__((ext_vector_type(4)));

constexpr int MTOK = 65536, DM = 1024, DFF = 2816, SEQL = 8192, CT = 32, NCHUNK = MTOK / CT  , NTHR = 512, NWAV = 8;
constexpr float RMS_EPS = 1e-6f;
constexpr size_t MiB = 1024ull * 1024ull;
constexpr size_t WS_XN = 0;
constexpr size_t WS_F = WS_XN + 128 * MiB;
constexpr size_t WS_BIG = WS_F + 128 * MiB;
constexpr size_t WS_ZS = WS_BIG, WS_SLOC = WS_BIG + 96 * MiB, WS_YG = WS_BIG + 160 * MiB;
constexpr size_t WS_WGU = WS_BIG + 384 * MiB;
constexpr size_t SZ_WGU = (size_t)5632 * 1024 * 2;
constexpr size_t WS_WD = WS_WGU + 8 * SZ_WGU;
constexpr size_t SZ_WD = (size_t)1024 * 2816 * 2;
constexpr size_t WS_WIN = WS_WD + 8 * SZ_WD;
constexpr size_t WS_WCAT = WS_WIN + 4 * MiB;
constexpr size_t WS_WGLU = WS_WCAT + 4 * MiB;
constexpr size_t WS_WQKV = WS_WGLU + 1 * MiB;
constexpr size_t WS_WO = WS_WQKV + 12 * MiB;
constexpr size_t WS_MTOEP = WS_WO + 4 * MiB;
constexpr size_t SZ_MTOEP = (size_t)512 * 768 * 2;
constexpr size_t WS_WST = WS_MTOEP + 64 * SZ_MTOEP;
constexpr size_t SZ_WST = (size_t)256 * 512 * 2;
constexpr size_t WS_LAMPOW = WS_WST + 64 * SZ_WST;
constexpr size_t WS_BBAR = WS_LAMPOW + 4 * MiB;
constexpr size_t WS_KTAB = WS_BBAR + 1 * MiB;
constexpr size_t WS_BAR = WS_KTAB + 4 * MiB;
constexpr size_t BAR_BYTES = 16384;
constexpr size_t WS_PCNT = WS_BAR + 14336;
constexpr size_t WS_RS = WS_BAR + BAR_BYTES;
constexpr size_t WS_XS = WS_RS + (size_t)MTOK * 16;
constexpr size_t WS_ATB = WS_XS + (size_t)MTOK * 16;
constexpr size_t WS_END = WS_ATB + 16 * MiB;
constexpr int LDS_BYTES = 131072 + 8192;

struct Args {
    const float *x, *norm_g, *w_gate, *w_up, *w_down, *ab_w_in, *pool_w, *pool_scale, *A_re, *A_im, *log_dt, *B_re, *B_im, *C_re, *C_im, *ssm_D, *w_glu, *b_glu, *ab_w_out, *w_qkv, *rpb, *na_w_out;
    float* out; unsigned char* ws; int ph_lo, ph_hi;
};

typedef const Args __attribute__((address_space(4)))* ArgsP;
__device__ __forceinline__ ArgsP args_ptr() { unsigned long long v = (unsigned long long)__builtin_amdgcn_kernarg_segment_ptr(); asm volatile("" : "+s"(v)); return (ArgsP)v; }
__device__ __forceinline__ unsigned cvt_pk_bf16(float lo, float hi) { unsigned r; asm volatile("v_cvt_pk_bf16_f32 %0, %1, %2" : "=v"(r) : "v"(lo), "v"(hi)); return r; }
__device__ __forceinline__ float bf_lo(unsigned w) { return __uint_as_float(w << 16); }
__device__ __forceinline__ float bf_hi(unsigned w) { return __uint_as_float(w & 0xffff0000u); }
__device__ __forceinline__ u32x4 pack8(const f32x4 a, const f32x4 b) { u32x4 w; w.x = cvt_pk_bf16(a[0], a[1]); w.y = cvt_pk_bf16(a[2], a[3]); w.z = cvt_pk_bf16(b[0], b[1]); w.w = cvt_pk_bf16(b[2], b[3]); return w; }
__device__ __forceinline__ float sigmoidf_(float v) { return __builtin_amdgcn_rcpf(1.0f + __builtin_amdgcn_exp2f(-1.4426950408889634f * v)); }
__device__ __forceinline__ float gelu_tanh(float v) { const float u = (1.5957691216057308f * 1.4426950408889634f) * (v + 0.044715f * v * v * v); return v * __builtin_amdgcn_rcpf(1.0f + __builtin_amdgcn_exp2f(-u)); }
__device__ __forceinline__ float wave_sum(float v) {
#pragma unroll
    for (int o = 1; o < 64; o <<= 1) v += __shfl_xor(v, o);
    return v;
}

#define XB_TMO      128
#define XB_XCNT(j)  (256  + 64 * (j))
#define XB_XSUB(j)  (1280 + 64 * (j))
#define XB_XGEN(j)  (2304 + 64 * (j))
#define XB_TOP      3328
#define XB_TOPGEN   3392
#define XCD_BAR_WORDS 3456
#define XB_SPIN_CAP (1u << 18)

__device__ __forceinline__ unsigned xb_ld(unsigned* p)              { return __hip_atomic_load(p, __ATOMIC_RELAXED, __HIP_MEMORY_SCOPE_AGENT); }
__device__ __forceinline__ unsigned xb_add(unsigned* p, unsigned v) { return __hip_atomic_fetch_add(p, v, __ATOMIC_RELAXED, __HIP_MEMORY_SCOPE_AGENT); }
__device__ __forceinline__ unsigned xb_xcc_id() { return (unsigned)__builtin_amdgcn_s_getreg((3 << 11) | 20) & 0xFu; }
#define XB_SPIN(cond, bar) do { unsigned _sp = 0; while (cond) { __builtin_amdgcn_s_sleep(1); \
    if ((++_sp & 255u) == 0u) { if (xb_ld(&(bar)[XB_TMO])) break; if (_sp > XB_SPIN_CAP) { atomicAdd(&(bar)[XB_TMO], 1u); break; } } } } while (0)

struct XcdBarrier {
    unsigned* bar; unsigned x;
    volatile LAS unsigned* st;
};

__device__ __forceinline__ XcdBarrier xcd_barrier_post(unsigned* bar, volatile LAS unsigned* st) {
    XcdBarrier b; b.bar = bar; b.x = xb_xcc_id(); b.st = st;
    if (threadIdx.x == 0) (void)xb_add(&bar[XB_XCNT(b.x)], 1u);
    return b;
}
__device__ __forceinline__ void xcd_barrier_complete(unsigned* bar, unsigned x, unsigned& nloc, unsigned& nx) {
    const unsigned G = gridDim.x * gridDim.y * gridDim.z;
    unsigned sum, cnt, mine, sp = 0u;
    for (;;) {
        sum = 0u; cnt = 0u; mine = 0u;
#pragma unroll
        for (unsigned j = 0; j < 16; ++j) { const unsigned c = xb_ld(&bar[XB_XCNT(j)]); sum += c; cnt += (c > 0u) ? 1u : 0u; mine = (j == x) ? c : mine; }
        if (sum == G) break;
        __builtin_amdgcn_s_sleep(1);
        if ((++sp & 255u) == 0u) { if (xb_ld(&bar[XB_TMO])) break; if (sp > XB_SPIN_CAP) { atomicAdd(&bar[XB_TMO], 1u); break; } }
    }
    nloc = mine > 0u ? mine : 1u; nx = cnt > 0u ? cnt : 1u;
}

__device__ __forceinline__ void xcd_barrier(const XcdBarrier& b) {
    asm volatile("s_waitcnt vmcnt(0)" ::: "memory");
    __syncthreads();
    if (threadIdx.x == 0) {
        unsigned* bar = b.bar;
        __builtin_amdgcn_s_waitcnt(0);
        unsigned nloc = b.st[0], nx = b.st[1];
        if (nloc == 0u) { xcd_barrier_complete(bar, b.x, nloc, nx); b.st[0] = nloc; b.st[1] = nx; }
        const unsigned old = xb_add(&bar[XB_XSUB(b.x)], 1u);
        const unsigned gen = old / nloc;
        if (old + 1u == (gen + 1u) * nloc) {
            __builtin_amdgcn_fence(__ATOMIC_RELEASE, "agent");
            asm volatile("s_waitcnt vmcnt(0)" ::: "memory");
            const unsigned og = xb_add(&bar[XB_TOP], 1u);
            const unsigned tg = og / nx;
            if (og + 1u == (tg + 1u) * nx) xb_add(&bar[XB_TOPGEN], 1u);
            else XB_SPIN(xb_ld(&bar[XB_TOPGEN]) == tg, bar);
            __builtin_amdgcn_fence(__ATOMIC_ACQUIRE, "agent");
            xb_add(&bar[XB_XGEN(b.x)], 1u);
            asm volatile("s_waitcnt vmcnt(0)" ::: "memory");
        } else {
            XB_SPIN(xb_ld(&bar[XB_XGEN(b.x)]) == gen, bar);
            __builtin_amdgcn_fence(__ATOMIC_ACQUIRE, "agent");
            asm volatile("s_waitcnt vmcnt(0)" ::: "memory");
        }
    }
    __syncthreads();
}

__device__ __forceinline__ void unpack8(const u32x4 w, float (&v)[8]) { v[0] = bf_lo(w.x); v[1] = bf_hi(w.x); v[2] = bf_lo(w.y); v[3] = bf_hi(w.y); v[4] = bf_lo(w.z); v[5] = bf_hi(w.z); v[6] = bf_lo(w.w); v[7] = bf_hi(w.w); }
__device__ __forceinline__ float row_rs(const float* RSP, int row) { const f32x4 p = *(const f32x4*)(RSP + (size_t)row * 4); return rsqrtf(((p[0] + p[1]) + (p[2] + p[3])) * (1.0f / DM) + RMS_EPS); }
__device__ __forceinline__ void row_rs8(const float* RSP, int row0, float (&rs)[2][4]) {
    f32x4 p[2][4];
#pragma unroll
    for (int ai = 0; ai < 2; ++ai)
#pragma unroll
        for (int m = 0; m < 4; ++m) p[ai][m] = *(const f32x4*)(RSP + (size_t)(row0 + ai * 128 + m * 16) * 4);
#pragma unroll
    for (int ai = 0; ai < 2; ++ai)
#pragma unroll
        for (int m = 0; m < 4; ++m) rs[ai][m] = rsqrtf(((p[ai][m][0] + p[ai][m][1]) + (p[ai][m][2] + p[ai][m][3])) * (1.0f / DM) + RMS_EPS);
    asm volatile("" : "+v"(rs[0][0]), "+v"(rs[0][1]), "+v"(rs[0][2]), "+v"(rs[0][3]), "+v"(rs[1][0]), "+v"(rs[1][1]), "+v"(rs[1][2]), "+v"(rs[1][3]));
}
__device__ __forceinline__ void rsl_fill(LAS float* rsl, const float* RSP, int bx, int tid) {
#pragma unroll
    for (int k = 0; k < 4; ++k) { const int pmk = 8 * ((bx % 8) * 4 + k) + ((bx / 8) % 8); if (tid < 256) rsl[k * 256 + tid] = row_rs(RSP, pmk * 256 + tid); }
    __syncthreads();
}
__device__ __forceinline__ void rsl_read(const LAS float* RSL, int pm, int wr, int fr, float (&rs)[2][4]) {
    int frl = fr; asm volatile("" : "+v"(frl));
    const LAS float* t = RSL + ((pm >> 3) & 3) * 256 + wr * 64 + frl;
#pragma unroll
    for (int ai = 0; ai < 2; ++ai)
#pragma unroll
        for (int m = 0; m < 4; ++m) rs[ai][m] = t[ai * 128 + m * 16];
}
struct EpiPlain {
    static constexpr bool PERM = true, AFTER_DRAIN = false;
    bf16_t* O; int ldc; const float* RS;
    __device__ __forceinline__ void operator()(const f32x4 (&acc)[2][2][4][2], const Unit& u, int wr, int wc, int fr, int fq) const {
        const int row0 = u.pm * 256 + wr * 64 + fr, col0 = u.pn * 256 + wc * 32 + 8 * fq;
        float rsv[2][4];
        if (RS) row_rs8(RS, row0, rsv);
#pragma unroll
        for (int ai = 0; ai < 2; ++ai)
#pragma unroll
            for (int m = 0; m < 4; ++m) { const int row = row0 + ai * 128 + m * 16; bf16_t* rowp = O + (size_t)row * ldc + col0; const float rs = RS ? rsv[ai][m] : 1.0f;
#pragma unroll
                for (int bj = 0; bj < 2; ++bj) *(u32x4*)(rowp + bj * 128) = pack8(acc[ai][bj][m][0] * rs, acc[ai][bj][m][1] * rs); }
    }
};
struct EpiQKV {
    static constexpr bool PERM = true, AFTER_DRAIN = false;
    bf16_t* O; const LAS float* RSL;
    __device__ __forceinline__ void operator()(const f32x4 (&acc)[2][2][4][2], const Unit& u, int wr, int wc, int fr, int fq) const {
        const int row0 = u.pm * 256 + wr * 64 + fr;
        float rsv[2][4]; rsl_read(RSL, u.pm, wr, fr, rsv);
#pragma unroll
        for (int ai = 0; ai < 2; ++ai)
#pragma unroll
            for (int m = 0; m < 4; ++m) { const int row = row0 + ai * 128 + m * 16, b = row >> 13, t = row & (SEQL - 1); const float rs = rsv[ai][m];
#pragma unroll
                for (int bj = 0; bj < 2; ++bj) { const int col = u.pn * 256 + bj * 128 + wc * 32 + 8 * fq, which = col >> 10, hc = col & 1023, h = hc >> 6, dd = hc & 63;
                    *(u32x4*)(O + (size_t)which * ((size_t)MTOK * DM) + ((size_t)(b * 16 + h) * SEQL + t) * 64 + dd) = pack8(acc[ai][bj][m][0] * rs, acc[ai][bj][m][1] * rs); } }
    }
};
struct EpiSwiglu {
    static constexpr bool PERM = true, AFTER_DRAIN = false;
    bf16_t* O; const LAS float* RSL;
    __device__ __forceinline__ void operator()(const f32x4 (&acc)[2][2][4][2], const Unit& u, int wr, int wc, int fr, int fq) const {
        const int row0 = u.pm * 256 + wr * 64 + fr, col0 = u.pn * 128 + wc * 32 + 8 * fq;
        float rsv[2][4]; { int frl = fr; asm volatile("" : "+v"(frl));
            const LAS float* t = RSL + ((u.pm >> 3) & 3) * 256 + wr * 64 + frl;
#pragma unroll
            for (int ai = 0; ai < 2; ++ai)
#pragma unroll
                for (int m = 0; m < 4; ++m) rsv[ai][m] = t[ai * 128 + m * 16]; }
#pragma unroll
        for (int ai = 0; ai < 2; ++ai)
#pragma unroll
            for (int m = 0; m < 4; ++m) { f32x4 v[2]; const float rs = rsv[ai][m], rsl = rs * -1.4426950408889634f, rs2 = rs * rs;
#pragma unroll
                for (int n = 0; n < 2; ++n) {
                    const f32x4 gt = acc[ai][0][m][n], up = acc[ai][1][m][n]; const f32x4 pr = gt * up, ar = gt * rsl; f32x4 ex;
#pragma unroll
                    for (int e = 0; e < 4; ++e) ex[e] = __builtin_amdgcn_exp2f(ar[e]);
                    const f32x4 dn = ex + 1.0f; f32x4 rc;
#pragma unroll
                    for (int e = 0; e < 4; ++e) rc[e] = __builtin_amdgcn_rcpf(dn[e]);
                    v[n] = (pr * rs2) * rc; }
                __builtin_nontemporal_store(pack8(v[0], v[1]), (u32x4*)(O + (size_t)(row0 + ai * 128 + m * 16) * DFF + col0)); }
    }
};
struct EpiZ {
    static constexpr bool PERM = true, AFTER_DRAIN = false;
    bf16_t* ZP; bf16_t* ZS; const LAS float* RSL;
    __device__ __forceinline__ void operator()(const f32x4 (&acc)[2][2][4][2], const Unit& u, int wr, int wc, int fr, int fq) const {
        const int row0 = u.pm * 256 + wr * 64 + fr;
        float rsv[2][4]; rsl_read(RSL, u.pm, wr, fr, rsv);
#pragma unroll
        for (int ai = 0; ai < 2; ++ai)
#pragma unroll
            for (int m = 0; m < 4; ++m) { const int row = row0 + ai * 128 + m * 16; const float rs = rsv[ai][m];
#pragma unroll
                for (int bj = 0; bj < 2; ++bj) { const int col = u.pn * 256 + bj * 128 + wc * 32 + 8 * fq; const u32x4 w = pack8(acc[ai][bj][m][0] * rs, acc[ai][bj][m][1] * rs);
                    if (u.pn < 2) *(u32x4*)(ZP + (size_t)row * 512 + col) = w;
                    else { const int cs = col - 512, g = cs >> 4, h0 = cs & 15; *(u32x4*)(ZS + ((size_t)g * NCHUNK + (row >> 5)) * 768 + (row & 31) * 16 + h0) = w; } } }
    }
};
struct EpiState {
    static constexpr bool PERM = true, AFTER_DRAIN = false;
    float* S;
    __device__ __forceinline__ void operator()(const f32x4 (&acc)[2][2][4][2], const Unit& u, int wr, int wc, int fr, int fq) const {
        const int row0 = u.pm * 256 + wr * 64 + fr, col0 = wc * 32 + 8 * fq;
#pragma unroll
        for (int ai = 0; ai < 2; ++ai)
#pragma unroll
            for (int m = 0; m < 4; ++m) { float* rowp = S + ((size_t)u.pb * NCHUNK + row0 + ai * 128 + m * 16) * 256 + col0;
#pragma unroll
                for (int bj = 0; bj < 2; ++bj) { *(f32x4*)(rowp + bj * 128) = acc[ai][bj][m][0]; *(f32x4*)(rowp + bj * 128 + 4) = acc[ai][bj][m][1]; } }
    }
};
struct EpiSsmOut {
    static constexpr bool PERM = true, AFTER_DRAIN = false;
    bf16_t* YG;
    __device__ __forceinline__ void operator()(const f32x4 (&acc)[2][2][4][2], const Unit& u, int wr, int wc, int fr, int fq) const {
        const int row0 = u.pm * 256 + wr * 64 + fr;
#pragma unroll
        for (int ai = 0; ai < 2; ++ai)
#pragma unroll
            for (int m = 0; m < 4; ++m) { const int crow = row0 + ai * 128 + m * 16;
#pragma unroll
                for (int bj = 0; bj < 2; ++bj) { const int col = u.pn * 256 + bj * 128 + wc * 32 + 8 * fq, t = col >> 4, h0 = col & 15; f32x4 v[2];
#pragma unroll
                    for (int n = 0; n < 2; ++n)
#pragma unroll
                        for (int e = 0; e < 4; ++e) v[n][e] = gelu_tanh(acc[ai][bj][m][n][e]);
                    *(u32x4*)(YG + ((size_t)crow * CT + t) * 512 + u.pb * 16 + h0) = pack8(v[0], v[1]); } }
    }
};
struct EpiGlu {
    static constexpr bool PERM = true, AFTER_DRAIN = false;
    const bf16_t* YG; const float* bias; bf16_t* CAT;
    __device__ __forceinline__ void operator()(const f32x4 (&acc)[2][2][4][2], const Unit& u, int wr, int wc, int fr, int fq) const {
        const int row0 = u.pm * 256 + wr * 64 + fr;
        u32x4 yv[2][2][4]; f32x4 bv[2][2];
#pragma unroll
        for (int bj = 0; bj < 2; ++bj) { const int col = u.pn * 256 + bj * 128 + wc * 32 + 8 * fq; bv[bj][0] = *(const f32x4*)(bias + col); bv[bj][1] = *(const f32x4*)(bias + col + 4);
#pragma unroll
            for (int ai = 0; ai < 2; ++ai)
#pragma unroll
                for (int m = 0; m < 4; ++m) yv[bj][ai][m] = *(const u32x4*)(YG + (size_t)(row0 + ai * 128 + m * 16) * 512 + col); }
        asm volatile("" ::: "memory");
#pragma unroll
        for (int bj = 0; bj < 2; ++bj) { const int col = u.pn * 256 + bj * 128 + wc * 32 + 8 * fq;
#pragma unroll
            for (int ai = 0; ai < 2; ++ai)
#pragma unroll
                for (int m = 0; m < 4; ++m) { const int row = row0 + ai * 128 + m * 16; const u32x4 y = yv[bj][ai][m];
                    f32x4 v0, v1; const f32x4 a0 = acc[ai][bj][m][0] + bv[bj][0], a1 = acc[ai][bj][m][1] + bv[bj][1];
                    v0[0] = bf_lo(y.x) * sigmoidf_(a0[0]); v0[1] = bf_hi(y.x) * sigmoidf_(a0[1]); v0[2] = bf_lo(y.y) * sigmoidf_(a0[2]); v0[3] = bf_hi(y.y) * sigmoidf_(a0[3]);
                    v1[0] = bf_lo(y.z) * sigmoidf_(a1[0]); v1[1] = bf_hi(y.z) * sigmoidf_(a1[1]); v1[2] = bf_lo(y.w) * sigmoidf_(a1[2]); v1[3] = bf_hi(y.w) * sigmoidf_(a1[3]);
                    *(u32x4*)(CAT + (size_t)row * 1024 + 512 + col) = pack8(v0, v1); } }
    }
};

struct EpiResNorm {
    static constexpr bool PERM = true, AFTER_DRAIN = false;
    bf16_t* HB; const float* ga; float alpha; float* XS; float* RSP; unsigned* cnt; unsigned need; float* OUT; LAS unsigned char* misc;
    __device__ __forceinline__ void operator()(const f32x4 (&acc)[2][2][4][2], const Unit& u, int wr, int wc, int fr, int fq) const {
        LAS float* P = (LAS float*)misc; LAS float* S = (LAS float*)(misc + 4096);
        const int tid = threadIdx.x, rloc0 = wr * 64 + fr, colb = u.pn * 256 + wc * 32 + 8 * fq; const size_t grow0 = (size_t)u.pm * 256;
        f32x4 g[2][2];
#pragma unroll
        for (int bj = 0; bj < 2; ++bj) { g[bj][0] = *(const f32x4*)(ga + colb + bj * 128); g[bj][1] = *(const f32x4*)(ga + colb + bj * 128 + 4); }
        u32x4 pre[4][2];
#pragma unroll
        for (int m = 0; m < 4; ++m)
#pragma unroll
            for (int bj = 0; bj < 2; ++bj) pre[m][bj] = *(const u32x4*)(HB + (grow0 + rloc0 + m * 16) * DM + colb + bj * 128);
#pragma unroll
        for (int ai = 0; ai < 2; ++ai)
#pragma unroll
            for (int m = 0; m < 4; ++m) { float q = 0.f;
#pragma unroll
                for (int bj = 0; bj < 2; ++bj)
#pragma unroll
                    for (int n = 0; n < 2; ++n) { const f32x4 x = acc[ai][bj][m][n]; q += (x[0] * x[0] + x[1] * x[1]) + (x[2] * x[2] + x[3] * x[3]); }
                q += __shfl_xor(q, 16); q += __shfl_xor(q, 32);
                if (fq == 0) P[(rloc0 + ai * 128 + m * 16) * 4 + wc] = q; }
        asm volatile("s_waitcnt lgkmcnt(0)" ::: "memory"); __builtin_amdgcn_s_barrier(); asm volatile("" ::: "memory");
        if (tid < 256) { const float tot = (P[tid * 4 + 0] + P[tid * 4 + 1]) + (P[tid * 4 + 2] + P[tid * 4 + 3]);
            __hip_atomic_store((unsigned*)(XS + (grow0 + tid) * 4 + u.pn), __float_as_uint(tot), __ATOMIC_RELAXED, __HIP_MEMORY_SCOPE_AGENT); }
        asm volatile("s_waitcnt vmcnt(0) lgkmcnt(0)" ::: "memory"); __builtin_amdgcn_s_barrier(); asm volatile("" ::: "memory");
        if (tid == 0) { (void)__hip_atomic_fetch_add(cnt + u.pm, 1u, __ATOMIC_RELAXED, __HIP_MEMORY_SCOPE_AGENT); unsigned sp = 0;
            while (__hip_atomic_load(cnt + u.pm, __ATOMIC_RELAXED, __HIP_MEMORY_SCOPE_AGENT) < need) { __builtin_amdgcn_s_sleep(1); if (++sp > (1u << 22)) break; } }
        asm volatile("s_waitcnt vmcnt(0) lgkmcnt(0)" ::: "memory"); __builtin_amdgcn_s_barrier(); asm volatile("" ::: "memory");
        if (tid < 256) { float ss = 0.f;
#pragma unroll
            for (int t = 0; t < 4; ++t) ss += __uint_as_float(__hip_atomic_load((unsigned*)(XS + (grow0 + tid) * 4 + t), __ATOMIC_RELAXED, __HIP_MEMORY_SCOPE_AGENT));
            S[tid] = alpha * rsqrtf(ss * (1.0f / DM) + RMS_EPS); }
        asm volatile("s_waitcnt vmcnt(0) lgkmcnt(0)" ::: "memory"); __builtin_amdgcn_s_barrier(); asm volatile("" ::: "memory");
#pragma unroll
        for (int ai = 0; ai < 2; ++ai)
#pragma unroll
            for (int m = 0; m < 4; ++m) { const int rloc = rloc0 + ai * 128 + m * 16; const float rs = S[rloc]; float q2 = 0.f;
                u32x4 cur[2]; cur[0] = pre[m][0]; cur[1] = pre[m][1];
                if (ai == 0) {
#pragma unroll
                    for (int bj = 0; bj < 2; ++bj) pre[m][bj] = *(const u32x4*)(HB + (grow0 + rloc + 128) * DM + colb + bj * 128); }
#pragma unroll
                for (int bj = 0; bj < 2; ++bj) { float h[8]; unpack8(cur[bj], h);
#pragma unroll
                    for (int e = 0; e < 4; ++e) { h[e] += acc[ai][bj][m][0][e] * g[bj][0][e] * rs; h[4 + e] += acc[ai][bj][m][1][e] * g[bj][1][e] * rs; }
                    if (OUT) { float* op = OUT + (grow0 + rloc) * DM + colb + bj * 128; *(f32x4*)op = (f32x4){h[0], h[1], h[2], h[3]}; *(f32x4*)(op + 4) = (f32x4){h[4], h[5], h[6], h[7]}; }
                    else { u32x4 w; w.x = cvt_pk_bf16(h[0], h[1]); w.y = cvt_pk_bf16(h[2], h[3]); w.z = cvt_pk_bf16(h[4], h[5]); w.w = cvt_pk_bf16(h[6], h[7]);
                        *(u32x4*)(HB + (grow0 + rloc) * DM + colb + bj * 128) = w; float qv[8]; unpack8(w, qv);
#pragma unroll
                        for (int e = 0; e < 8; ++e) q2 += qv[e] * qv[e]; } }
                q2 += __shfl_xor(q2, 16); q2 += __shfl_xor(q2, 32);
                if (fq == 0) P[rloc * 4 + wc] = q2; }
        asm volatile("s_waitcnt lgkmcnt(0)" ::: "memory"); __builtin_amdgcn_s_barrier(); asm volatile("" ::: "memory");
        if (tid < 256 && !OUT) RSP[(grow0 + tid) * 4 + u.pn] = (P[tid * 4 + 0] + P[tid * 4 + 1]) + (P[tid * 4 + 2] + P[tid * 4 + 3]);
        asm volatile("s_waitcnt lgkmcnt(0)" ::: "memory"); __builtin_amdgcn_s_barrier(); asm volatile("" ::: "memory");
    }
};
struct BatchOrder {
    int nM, nN, nB, G, c;
    __device__ void init(int M, int N, int B, int G_, int c_) { nM = M / 256; nN = N / 256; nB = B; G = G_; c = c_; }
    __device__ bool next(int i, Unit& u) const { const int L = i * G + c; if (L >= nM * nN * nB) return false; u.pb = L / (nM * nN); const int r = L % (nM * nN); u.pn = r / nM; u.pm = r % nM; return true; }
    __device__ __forceinline__ void a_ready(const Unit&) const {}
    __device__ __forceinline__ void done(const Unit&) const {}
};
__device__ __forceinline__ void rowwise_phase(const float* X, bf16_t* HB, const bf16_t* F, const float* ga, float alpha, float* RS, float* OUT, int gw, int NGW, int lane) {
    for (int row0 = gw; row0 < MTOK; row0 += 4 * NGW) {
        float h[4][2][8]; u32x4 fw[4][2];
#pragma unroll
        for (int r = 0; r < 4; ++r) { const int row = row0 + r * NGW;
#pragma unroll
            for (int j = 0; j < 2; ++j) {
                if (X) { const f32x4 a0 = __builtin_nontemporal_load((const f32x4*)(X + (size_t)row * DM + 8 * lane + 512 * j)), a1 = __builtin_nontemporal_load((const f32x4*)(X + (size_t)row * DM + 8 * lane + 512 * j + 4));
                    h[r][j][0] = a0[0]; h[r][j][1] = a0[1]; h[r][j][2] = a0[2]; h[r][j][3] = a0[3]; h[r][j][4] = a1[0]; h[r][j][5] = a1[1]; h[r][j][6] = a1[2]; h[r][j][7] = a1[3]; }
                else { const u32x4 w = *(const u32x4*)(HB + (size_t)row * DM + 8 * lane + 512 * j); unpack8(w, h[r][j]); }
                if (F) fw[r][j] = *(const u32x4*)(F + (size_t)row * DM + 8 * lane + 512 * j); } }
#pragma unroll
        for (int r = 0; r < 4; ++r) { const int row = row0 + r * NGW;
            if (F) { float f[2][8]; float ss = 0.f;
#pragma unroll
                for (int j = 0; j < 2; ++j) { unpack8(fw[r][j], f[j]);
#pragma unroll
                    for (int e = 0; e < 8; ++e) ss += f[j][e] * f[j][e]; }
                const float rs = alpha * rsqrtf(wave_sum(ss) * (1.0f / DM) + RMS_EPS);
#pragma unroll
                for (int j = 0; j < 2; ++j) { const f32x4 g0 = *(const f32x4*)(ga + 8 * lane + 512 * j), g1 = *(const f32x4*)(ga + 8 * lane + 512 * j + 4);
#pragma unroll
                    for (int e = 0; e < 4; ++e) { h[r][j][e] += f[j][e] * g0[e] * rs; h[r][j][4 + e] += f[j][4 + e] * g1[e] * rs; } } }
            if (OUT) {
#pragma unroll
                for (int j = 0; j < 2; ++j) { *(f32x4*)(OUT + (size_t)row * DM + 8 * lane + 512 * j) = (f32x4){h[r][j][0], h[r][j][1], h[r][j][2], h[r][j][3]}; *(f32x4*)(OUT + (size_t)row * DM + 8 * lane + 512 * j + 4) = (f32x4){h[r][j][4], h[r][j][5], h[r][j][6], h[r][j][7]}; }
            } else { float ss = 0.f;
#pragma unroll
                for (int j = 0; j < 2; ++j) { u32x4 w; w.x = cvt_pk_bf16(h[r][j][0], h[r][j][1]); w.y = cvt_pk_bf16(h[r][j][2], h[r][j][3]); w.z = cvt_pk_bf16(h[r][j][4], h[r][j][5]); w.w = cvt_pk_bf16(h[r][j][6], h[r][j][7]);
                    *(u32x4*)(HB + (size_t)row * DM + 8 * lane + 512 * j) = w; float q[8]; unpack8(w, q);
#pragma unroll
                    for (int e = 0; e < 8; ++e) ss += q[e] * q[e]; }
                ss = wave_sum(ss); if (lane == 0) *(f32x4*)(RS + (size_t)row * 4) = (f32x4){ss, 0.f, 0.f, 0.f}; }
        }
    }
}

struct TItem { const float* W; bf16_t* WT; const float* gk; int ldw, k0, n0, ldt, orow0; float scale; };
__device__ __forceinline__ TItem titem_decode(ArgsP a, int it) {
    constexpr int I_FFN = 4224, N_FFN = 8 * I_FFN, I_MIX = 2944;
    const float* W; int ldw, nblk, ldt, orow_add = 0, r; bf16_t* WT; float scale = 1.f; bool il = false; const float* gk = nullptr;
    if (it < N_FFN) { const int f = it / I_FFN; r = it % I_FFN; const int which = r / 1408; r = r % 1408; if (which < 2) gk = a->norm_g + (size_t)((f >> 1) * 6 + ((f & 1) ? 4 : 0)) * DM;
        if (which == 0) { W = a->w_gate + (size_t)f * DM * DFF; ldw = DFF; nblk = 88; WT = (bf16_t*)(a->ws + WS_WGU + f * SZ_WGU); ldt = DM; il = true; }
        else if (which == 1) { W = a->w_up + (size_t)f * DM * DFF; ldw = DFF; nblk = 88; WT = (bf16_t*)(a->ws + WS_WGU + f * SZ_WGU); ldt = DM; il = true; orow_add = 128; }
        else { W = a->w_down + (size_t)f * DFF * DM; ldw = DM; nblk = 32; WT = (bf16_t*)(a->ws + WS_WD + f * SZ_WD); ldt = DFF; }
    } else { const int it2 = it - N_FFN, i = it2 / I_MIX; r = it2 % I_MIX;
        if (r < 512) { gk = a->norm_g + (size_t)((2 * i) * 6 + 2) * DM; W = a->ab_w_in + (size_t)i * DM * DM; ldw = DM; nblk = 32; WT = (bf16_t*)(a->ws + WS_WIN) + (size_t)i * DM * DM; ldt = DM; }
        else if (r < 768) { r -= 512; W = a->ab_w_out + (size_t)i * DM * DM + (size_t)512 * DM; ldw = DM; nblk = 32; WT = (bf16_t*)(a->ws + WS_WCAT) + (size_t)i * DM * DM + 512; ldt = DM; }
        else if (r < 896) { r -= 768; W = a->w_glu + (size_t)i * 512 * 512; ldw = 512; nblk = 16; WT = (bf16_t*)(a->ws + WS_WGLU) + (size_t)i * 512 * 512; ldt = 512; }
        else if (r < 2432) { r -= 896; gk = a->norm_g + (size_t)((2 * i + 1) * 6 + 2) * DM; W = a->w_qkv + (size_t)i * DM * 3072; ldw = 3072; nblk = 96; WT = (bf16_t*)(a->ws + WS_WQKV) + (size_t)i * 3072 * DM; ldt = DM; if ((r % 96) < 32) scale = 0.125f * 1.4426950408889634f;     }
        else { r -= 2432; W = a->na_w_out + (size_t)i * DM * DM; ldw = DM; nblk = 32; WT = (bf16_t*)(a->ws + WS_WO) + (size_t)i * DM * DM; ldt = DM; }
    }
    const int kb = r / nblk, nb = r % nblk, n0 = 32 * nb;
    TItem t; t.W = W; t.WT = WT; t.gk = gk; t.ldw = ldw; t.k0 = 64 * kb; t.n0 = n0; t.ldt = ldt; t.orow0 = il ? ((n0 >> 7) * 256 + (n0 & 127) + orow_add) : n0; t.scale = scale; return t;
}
__device__ __forceinline__ void tile_load(const TItem& t, int lane, f32x4 (&v)[8], float (&gm)[8]) {
    const int n4 = lane & 7, kr = lane >> 3;
#pragma unroll
    for (int i = 0; i < 8; ++i) { v[i] = __builtin_nontemporal_load((const f32x4*)(t.W + (size_t)(t.k0 + kr + 8 * i) * t.ldw + t.n0 + 4 * n4));     gm[i] = t.gk ? t.gk[t.k0 + kr + 8 * i] : 1.0f; }
}
__device__ __forceinline__ void tile_store(const TItem& t, int lane, const f32x4 (&v)[8], const float (&gm)[8], LAS float* scr) {
    { const int n4 = lane & 7, kr = lane >> 3;
#pragma unroll
      for (int i = 0; i < 8; ++i) { LAS float* s = scr + (kr + 8 * i) * 33 + 4 * n4; s[0] = v[i][0] * gm[i]; s[1] = v[i][1] * gm[i]; s[2] = v[i][2] * gm[i]; s[3] = v[i][3] * gm[i]; } }
    asm volatile("s_waitcnt lgkmcnt(0)" ::: "memory");
    const int c = lane & 7;
#pragma unroll
    for (int j = 0; j < 4; ++j) { const int n = (lane >> 3) + 8 * j; const LAS float* s = scr + (8 * c) * 33 + n; const float scale = t.scale;
        u32x4 o; o.x = cvt_pk_bf16(s[0 * 33] * scale, s[1 * 33] * scale); o.y = cvt_pk_bf16(s[2 * 33] * scale, s[3 * 33] * scale); o.z = cvt_pk_bf16(s[4 * 33] * scale, s[5 * 33] * scale); o.w = cvt_pk_bf16(s[6 * 33] * scale, s[7 * 33] * scale);
        *(u32x4*)(t.WT + (size_t)(t.orow0 + n) * t.ldt + t.k0 + 8 * c) = o; }
    asm volatile("s_waitcnt lgkmcnt(0)" ::: "memory");
}
__device__ __forceinline__ void transposes_phase(ArgsP a, LAS float* scr, int gw, int NGW, int lane) {
    constexpr int N_ALL = 8 * 4224 + 2 * 2944;
    if (gw >= N_ALL) return;
    TItem cur = titem_decode(a, gw); f32x4 v[8]; float gm[8]; tile_load(cur, lane, v, gm);
    for (int it = gw; it < N_ALL; it += NGW) {
        const int nx = it + NGW; const bool has = nx < N_ALL; TItem nxt = cur; f32x4 vn[8]; float gn[8];
        if (has) { nxt = titem_decode(a, nx); tile_load(nxt, lane, vn, gn); }
        tile_store(cur, lane, v, gm, scr);
        if (has) { cur = nxt;
#pragma unroll
            for (int i = 0; i < 8; ++i) { v[i] = vn[i]; gm[i] = gn[i]; } }
    }
}

__device__ __forceinline__ void ssm_tables0(ArgsP a, int gt, int NGT) {
    float* LP = (float*)(a->ws + WS_LAMPOW); float* BB = (float*)(a->ws + WS_BBAR);
    for (int idx = gt; idx < 8192; idx += NGT) {
        const int q = idx >> 6, p = idx & 63;
        const float are = fminf(a->A_re[idx], -1e-4f), aim = a->A_im[idx], dt = expf(a->log_dt[q]);
        const float mag = expf(are * dt), lr = mag * cosf(aim * dt), li = mag * sinf(aim * dt);
        float pr = 1.f, pi = 0.f;
        for (int tau = 0; tau <= 32; ++tau) { *(float2*)(LP + ((size_t)(q * 33 + tau) * 64 + p) * 2) = make_float2(pr, pi); const float nr = pr * lr - pi * li, ni = pr * li + pi * lr; pr = nr; pi = ni; }
        const float nre = lr - 1.f, nim = li, den = are * are + aim * aim;
        const float fre = (nre * are + nim * aim) / den, fim = (nim * are - nre * aim) / den;
        for (int h = 0; h < 16; ++h) { const float br = a->B_re[(size_t)idx * 16 + h], bi = a->B_im[(size_t)idx * 16 + h];
            *(float2*)(BB + ((size_t)idx * 16 + h) * 2) = make_float2(fre * br - fim * bi, fre * bi + fim * br); }
    }
}
__device__ __forceinline__ void ssm_tables1(ArgsP a, int gt, int NGT) {
    const float2* LP = (const float2*)(a->ws + WS_LAMPOW); const float2* BB = (const float2*)(a->ws + WS_BBAR); float* KT = (float*)(a->ws + WS_KTAB);
    for (int o = gt; o < 128 * 32 * 256; o += NGT) {
        const int hp = o & 15, h = (o >> 4) & 15, tau = (o >> 8) & 31, q = o >> 13; float s = 0.f;
        for (int p = 0; p < 64; ++p) { const float cr = a->C_re[(size_t)q * 1024 + h * 64 + p], ci = a->C_im[(size_t)q * 1024 + h * 64 + p];
            const float2 l = LP[(size_t)(q * 33 + tau) * 64 + p], b = BB[((size_t)q * 64 + p) * 16 + hp];
            const float xr = l.x * b.x - l.y * b.y, xi = l.x * b.y + l.y * b.x; s += cr * xr - ci * xi; }
        KT[o] = s;
    }
    for (int o = gt; o < 2 * 32 * 256 * 64; o += NGT) {
        const int half = o & 1, s = (o >> 1) & 31, n = (o >> 6) & 255, ig = o >> 14, i = ig >> 5, g = ig & 31;
        const int dir = n >> 7, part = (n >> 6) & 1, p = n & 63, q = (i * 2 + dir) * 32 + g, e = dir == 0 ? 31 - s : s;
        const float2 l = LP[(size_t)(q * 33 + e) * 64 + p]; float v[8];
#pragma unroll
        for (int j = 0; j < 8; ++j) { const float2 b = BB[((size_t)q * 64 + p) * 16 + half * 8 + j]; v[j] = part == 0 ? (l.x * b.x - l.y * b.y) : (l.x * b.y + l.y * b.x); }
        u32x4 w; w.x = cvt_pk_bf16(v[0], v[1]); w.y = cvt_pk_bf16(v[2], v[3]); w.z = cvt_pk_bf16(v[4], v[5]); w.w = cvt_pk_bf16(v[6], v[7]);
        *(u32x4*)((bf16_t*)(a->ws + WS_WST + (size_t)ig * SZ_WST) + (size_t)n * 512 + s * 16 + half * 8) = w;
    }
    for (int o = gt; o < 2 * 32 * 512 * 32; o += NGT) {
        const int cblk = o & 31, n = (o >> 5) & 511, ig = o >> 14, i = ig >> 5, g = ig & 31;
        const int kind = cblk >> 3, p0 = (cblk & 7) * 8, dir = kind >> 1, q = (i * 2 + dir) * 32 + g, t = n >> 4, h = n & 15, e = dir == 0 ? t + 1 : 32 - t; float v[8];
#pragma unroll
        for (int j = 0; j < 8; ++j) { const int p = p0 + j; const float cr = a->C_re[(size_t)q * 1024 + h * 64 + p], ci = a->C_im[(size_t)q * 1024 + h * 64 + p]; const float2 l = LP[(size_t)(q * 33 + e) * 64 + p];
            v[j] = (kind & 1) == 0 ? (cr * l.x - ci * l.y) : -(cr * l.y + ci * l.x); }
        u32x4 w; w.x = cvt_pk_bf16(v[0], v[1]); w.y = cvt_pk_bf16(v[2], v[3]); w.z = cvt_pk_bf16(v[4], v[5]); w.w = cvt_pk_bf16(v[6], v[7]);
        *(u32x4*)((bf16_t*)(a->ws + WS_MTOEP + (size_t)ig * SZ_MTOEP) + (size_t)n * 768 + 512 + cblk * 8) = w;
    }
}
__device__ __forceinline__ void wcat_fold(ArgsP a, int gt, int NGT) {
    for (int o = gt; o < 2 * 4 * 16 * 1024; o += NGT) {
        const int n = o & 1023, c8 = (o >> 10) & 15, g = (o >> 14) & 3, i = o >> 16; float acc[8];
#pragma unroll
        for (int j = 0; j < 8; ++j) acc[j] = 0.f;
        const float* pw = a->pool_w + ((size_t)(i * 4 + g) * 128 + c8 * 8) * 128; const float* sc = a->pool_scale + i * 512 + g * 128; const float* wo = a->ab_w_out + (size_t)i * DM * DM + (size_t)(g * 128) * DM + n;
        for (int d = 0; d < 128; ++d) { const float x = sc[d] * wo[(size_t)d * DM];
#pragma unroll
            for (int j = 0; j < 8; ++j) acc[j] += pw[j * 128 + d] * x; }
        u32x4 w; w.x = cvt_pk_bf16(acc[0], acc[1]); w.y = cvt_pk_bf16(acc[2], acc[3]); w.z = cvt_pk_bf16(acc[4], acc[5]); w.w = cvt_pk_bf16(acc[6], acc[7]);
        *(u32x4*)((bf16_t*)(a->ws + WS_WCAT) + (size_t)i * DM * DM + (size_t)n * DM + g * 128 + c8 * 8) = w;
    }
}
__device__ __forceinline__ void ssm_tables2(ArgsP a, int gt, int NGT) {
    const float* KT = (const float*)(a->ws + WS_KTAB);
    for (int o = gt; o < 2 * 32 * 512 * 64; o += NGT) {
        const int half = o & 1, s = (o >> 1) & 31, n = (o >> 6) & 511, ig = o >> 15, i = ig >> 5, g = ig & 31, t = n >> 4, h = n & 15;
        const int qf = (i * 2) * 32 + g, qb = (i * 2 + 1) * 32 + g; float v[8];
#pragma unroll
        for (int j = 0; j < 8; ++j) v[j] = 0.f;
        if (s <= t) { const float* k = KT + ((size_t)(qf * 32 + (t - s)) * 16 + h) * 16 + half * 8;
#pragma unroll
            for (int j = 0; j < 8; ++j) v[j] += k[j]; }
        if (s >= t) { const float* k = KT + ((size_t)(qb * 32 + (s - t)) * 16 + h) * 16 + half * 8;
#pragma unroll
            for (int j = 0; j < 8; ++j) v[j] += k[j]; }
        if (s == t) { const float dsk = a->ssm_D[i * 512 + g * 16 + h];
#pragma unroll
            for (int j = 0; j < 8; ++j) if (half * 8 + j == h) v[j] += dsk; }
        u32x4 w; w.x = cvt_pk_bf16(v[0], v[1]); w.y = cvt_pk_bf16(v[2], v[3]); w.z = cvt_pk_bf16(v[4], v[5]); w.w = cvt_pk_bf16(v[6], v[7]);
        *(u32x4*)((bf16_t*)(a->ws + WS_MTOEP + (size_t)ig * SZ_MTOEP) + (size_t)n * 768 + s * 16 + half * 8) = w;
    }
}

__device__ __forceinline__ void attn_table(ArgsP a, int gt, int NGT) {
    float* TB = (float*)(a->ws + WS_ATB);
    for (int o = gt; o < 2 * 8 * 16 * 4 * 16 * 64; o += NGT) {
        const int lane = o & 63, it = (o >> 6) & 15, qt = (o >> 10) & 3, h = (o >> 12) & 15, v = (o >> 16) & 7, i = o >> 19;
        const int ii = it >> 1, t = it & 1, fr = lane & 15, fq = lane >> 4, kc0 = qt == 0 ? 0 : (qt == 1 ? 8 : (qt == 2 ? 24 : 32));
        const int c = 16 * qt + fr, cs = min(max(c - 8, 0), 48); f32x4 w;
#pragma unroll
        for (int e = 0; e < 4; ++e) { const int kc = kc0 + 16 * t + 4 * fq + e; const bool valid = (kc >= cs) && (kc < cs + 16);
            w[e] = valid ? a->rpb[((size_t)(i * 16 + h) * 15 + (ii - v + 7)) * 31 + (kc - c + 15)] * 1.4426950408889634f : -1e30f; }
        *(f32x4*)(TB + (size_t)o * 4) = w;
    }
}

__device__ __forceinline__ void pool_phase(const bf16_t* ZP, bf16_t* CAT, int gw, int NGW, int lane) {
    const int gi = lane >> 4, w = 2 << gi, lo = w >> 1, hi = w - 1 - lo;
    for (int row = gw; row < MTOK; row += NGW) {
        const int tl = row & (SEQL - 1); float acc[8];
#pragma unroll
        for (int j = 0; j < 8; ++j) acc[j] = 0.f;
        const int d0 = -min(lo, tl), d1 = min(hi, SEQL - 1 - tl);
#pragma unroll
        for (int d = -8; d <= 7; ++d) if (d >= d0 && d <= d1) { const u32x4 z = *(const u32x4*)(ZP + (size_t)(row + d) * 512 + lane * 8);
            acc[0] += bf_lo(z.x); acc[1] += bf_hi(z.x); acc[2] += bf_lo(z.y); acc[3] += bf_hi(z.y); acc[4] += bf_lo(z.z); acc[5] += bf_hi(z.z); acc[6] += bf_lo(z.w); acc[7] += bf_hi(z.w); }
        const float inv = 1.0f / (float)(d1 - d0 + 1); const u32x4 z = *(const u32x4*)(ZP + (size_t)row * 512 + lane * 8);
        u32x4 o; o.x = cvt_pk_bf16(acc[0] * inv - bf_lo(z.x), acc[1] * inv - bf_hi(z.x)); o.y = cvt_pk_bf16(acc[2] * inv - bf_lo(z.y), acc[3] * inv - bf_hi(z.y));
        o.z = cvt_pk_bf16(acc[4] * inv - bf_lo(z.z), acc[5] * inv - bf_hi(z.z)); o.w = cvt_pk_bf16(acc[6] * inv - bf_lo(z.w), acc[7] * inv - bf_hi(z.w));
        *(u32x4*)(CAT + (size_t)row * 1024 + lane * 8) = o;
    }
}

__device__ __forceinline__ void carry_phase(ArgsP a, int i, int wave, int lane, int G) {
    const float* __restrict__ SL = (const float*)(a->ws + WS_SLOC); bf16_t* __restrict__ ZS = (bf16_t*)(a->ws + WS_ZS); const float2* LP = (const float2*)(a->ws + WS_LAMPOW);
    for (int item = wave * G + (int)blockIdx.x; item < 512; item += NWAV * G) {
        const int dir = item & 1, b = (item >> 1) & 7, g = item >> 4, q = (i * 2 + dir) * 32 + g, p = lane;
        const float2 lt = LP[(size_t)(q * 33 + 32) * 64 + p]; float cr = 0.f, ci = 0.f;
        const size_t rbase = (size_t)g * NCHUNK + b * 256;
        for (int c0 = 0; c0 < 256; c0 += 16) {
            float sr[16], si[16];
#pragma unroll
            for (int k = 0; k < 16; ++k) { const int c = dir == 0 ? c0 + k : 255 - (c0 + k); const size_t row = rbase + c; sr[k] = SL[row * 256 + dir * 128 + p]; si[k] = SL[row * 256 + dir * 128 + 64 + p]; }
#pragma unroll
            for (int k = 0; k < 16; ++k) { const int c = dir == 0 ? c0 + k : 255 - (c0 + k); const size_t row = rbase + c;
                bf16_t* z = ZS + row * 768 + 512 + dir * 128 + p;
                z[0] = (bf16_t)(cvt_pk_bf16(cr, cr) & 0xffffu); z[64] = (bf16_t)(cvt_pk_bf16(ci, ci) & 0xffffu);
                const float nr = lt.x * cr - lt.y * ci + sr[k], ni = lt.x * ci + lt.y * cr + si[k]; cr = nr; ci = ni; }
        }
    }
}

__device__ __forceinline__ void attn_phase(LAS unsigned char* lds, const bf16_t* QKV, const float* TBL  , bf16_t* O, int tid, int wave, int lane, int G) {
    LAS unsigned char* vt = lds + wave * 9216;
    const unsigned vt_addr = (unsigned)(uintptr_t)vt;
    const int fr = lane & 15, fq = lane >> 4;
    for (int it = (int)blockIdx.x * NWAV + wave; it < 65536; it += G * NWAV) {
        const int qt = it & 3, h = (it >> 2) & 15, r = (it >> 6) & 127, b = it >> 13;
        const int r0 = min(max(r - 4, 0), 120), kc0 = qt == 0 ? 0 : (qt == 1 ? 8 : (qt == 2 ? 24 : 32));
        const int c = 16 * qt + fr;
        const size_t tokq = (size_t)b * SEQL + r * 64 + c;
        const float* tb = TBL + ((size_t)(((r - r0) * 16 + h) * 4 + qt) * 16) * 256 + lane * 4;
        bf16x8 qf[2];
        const bf16_t* qh = QKV + ((size_t)(b * 16 + h) * SEQL) * 64; const bf16_t* kh = qh + (size_t)MTOK * DM; const bf16_t* vh = kh + (size_t)MTOK * DM;
        {
            const bf16_t* qsrc = qh + (size_t)(r * 64 + 16 * qt + (lane >> 3)) * 64 + (lane & 7) * 8;
            const u32x4 q0 = *(const u32x4*)qsrc, q1 = *(const u32x4*)(qsrc + (size_t)8 * 64);
            *(LAS u32x4*)(vt + (lane >> 3) * 144 + (lane & 7) * 16) = q0; *(LAS u32x4*)(vt + ((lane >> 3) + 8) * 144 + (lane & 7) * 16) = q1;
            qf[0] = *(const LAS bf16x8*)(vt + fr * 144 + 16 * fq); qf[1] = *(const LAS bf16x8*)(vt + fr * 144 + 64 + 16 * fq);
            asm volatile("s_waitcnt lgkmcnt(0)" ::: "memory"); }
        const int vkey = lane >> 3, vch = lane & 7;
        const bf16_t* vsrc = vh + (size_t)(r0 * 64 + kc0 + vkey) * 64 + vch * 8;
        u32x4 vr[4][2][4];
        f32x4 s[8][2]; u32x4 kr[4][2][4];
        const bf16_t* ksrc = kh + (size_t)(r0 * 64 + kc0 + vkey) * 64 + vch * 8;
#pragma unroll
        for (int i = 0; i < 8; ++i) { const bf16_t* src = ksrc + (size_t)i * 64 * 64;
#pragma unroll
            for (int j = 0; j < 4; ++j) kr[i >> 1][i & 1][j] = *(const u32x4*)(src + (size_t)j * 8 * 64); }
#pragma unroll
        for (int i = 0; i < 8; ++i)
#pragma unroll
            for (int t = 0; t < 2; ++t) s[i][t] = i < 4 ? *(const f32x4*)(tb + (i * 2 + t) * 256) : (f32x4){0.f, 0.f, 0.f, 0.f};
        __builtin_amdgcn_sched_barrier(0);
        f32x4 tb2[4][2];
#pragma unroll
        for (int ip = 0; ip < 4; ++ip) {
#pragma unroll
            for (int rr = 0; rr < 2; ++rr) { LAS unsigned char* dst = vt + rr * 4608 + vkey * 144 + vch * 16;
#pragma unroll
                for (int j = 0; j < 4; ++j) *(LAS u32x4*)(dst + j * 8 * 144) = kr[ip][rr][j]; }
            if (ip == 1) {
#pragma unroll
                for (int i = 0; i < 4; ++i)
#pragma unroll
                    for (int t = 0; t < 2; ++t) tb2[i][t] = *(const f32x4*)(tb + ((i + 4) * 2 + t) * 256); }
#pragma unroll
            for (int rr = 0; rr < 2; ++rr)
#pragma unroll
                for (int t = 0; t < 2; ++t) { const LAS unsigned char* kp = vt + rr * 4608 + (16 * t + fr) * 144 + 16 * fq;
                    const bf16x8 k0 = *(const LAS bf16x8*)kp, k1 = *(const LAS bf16x8*)(kp + 64);
                    s[2 * ip + rr][t] = __builtin_amdgcn_mfma_f32_16x16x32_bf16(k0, qf[0], s[2 * ip + rr][t], 0, 0, 0); s[2 * ip + rr][t] = __builtin_amdgcn_mfma_f32_16x16x32_bf16(k1, qf[1], s[2 * ip + rr][t], 0, 0, 0); }
            asm volatile("s_waitcnt lgkmcnt(0)" ::: "memory");
        }
#pragma unroll
        for (int i = 0; i < 4; ++i)
#pragma unroll
            for (int t = 0; t < 2; ++t) s[i + 4][t] = s[i + 4][t] + tb2[i][t];
        __builtin_amdgcn_sched_barrier(0);
#pragma unroll
        for (int i = 0; i < 8; ++i) { const bf16_t* src = vsrc + (size_t)i * 64 * 64;
#pragma unroll
            for (int j = 0; j < 4; ++j) vr[i >> 1][i & 1][j] = *(const u32x4*)(src + (size_t)j * 8 * 64); }
        __builtin_amdgcn_sched_barrier(0);
        float mx = -1e30f;
#pragma unroll
        for (int i = 0; i < 8; ++i)
#pragma unroll
            for (int t = 0; t < 2; ++t) mx = fmaxf(fmaxf(mx, fmaxf(s[i][t][0], s[i][t][1])), fmaxf(s[i][t][2], s[i][t][3]));
        mx = fmaxf(mx, __shfl_xor(mx, 16)); mx = fmaxf(mx, __shfl_xor(mx, 32));
        float sum = 0.f;
#pragma unroll
        for (int i = 0; i < 8; ++i)
#pragma unroll
            for (int t = 0; t < 2; ++t)
#pragma unroll
                for (int e = 0; e < 4; ++e) { const float pe = __builtin_amdgcn_exp2f(s[i][t][e] - mx); s[i][t][e] = pe; sum += pe; }
        sum += __shfl_xor(sum, 16); sum += __shfl_xor(sum, 32);
        f32x4 o[4];
#pragma unroll
        for (int dt = 0; dt < 4; ++dt) o[dt] = (f32x4){0.f, 0.f, 0.f, 0.f};
        const unsigned ad = vt_addr + (unsigned)((4 * fq + (fr >> 2)) * 144 + 8 * (fr & 3));
#pragma unroll
        for (int ip = 0; ip < 4; ++ip) {
#pragma unroll
            for (int rr = 0; rr < 2; ++rr) { LAS unsigned char* dst = vt + rr * 4608 + vkey * 144 + vch * 16;
#pragma unroll
                for (int j = 0; j < 4; ++j) *(LAS u32x4*)(dst + j * 8 * 144) = vr[ip][rr][j]; }
            union { u32x4 w; bf16x8 v; } pf0, pf1; pf0.w = pack8(s[2 * ip][0], s[2 * ip][1]); pf1.w = pack8(s[2 * ip + 1][0], s[2 * ip + 1][1]);
            s16x4 ta0, ta1, ta2, ta3, tb0, tb1, tb2, tb3, ua0, ua1, ua2, ua3, ub0, ub1, ub2, ub3;
            asm volatile("ds_read_b64_tr_b16 %0, %16\n\tds_read_b64_tr_b16 %1, %16 offset:32\n\tds_read_b64_tr_b16 %2, %16 offset:64\n\tds_read_b64_tr_b16 %3, %16 offset:96\n\t"
                         "ds_read_b64_tr_b16 %4, %16 offset:2304\n\tds_read_b64_tr_b16 %5, %16 offset:2336\n\tds_read_b64_tr_b16 %6, %16 offset:2368\n\tds_read_b64_tr_b16 %7, %16 offset:2400\n\t"
                         "ds_read_b64_tr_b16 %8, %16 offset:4608\n\tds_read_b64_tr_b16 %9, %16 offset:4640\n\tds_read_b64_tr_b16 %10, %16 offset:4672\n\tds_read_b64_tr_b16 %11, %16 offset:4704\n\t"
                         "ds_read_b64_tr_b16 %12, %16 offset:6912\n\tds_read_b64_tr_b16 %13, %16 offset:6944\n\tds_read_b64_tr_b16 %14, %16 offset:6976\n\tds_read_b64_tr_b16 %15, %16 offset:7008\n\ts_waitcnt lgkmcnt(0)"
                         : "=&v"(ta0), "=&v"(ta1), "=&v"(ta2), "=&v"(ta3), "=&v"(tb0), "=&v"(tb1), "=&v"(tb2), "=&v"(tb3), "=&v"(ua0), "=&v"(ua1), "=&v"(ua2), "=&v"(ua3), "=&v"(ub0), "=&v"(ub1), "=&v"(ub2), "=&v"(ub3) : "v"(ad) : "memory");
            bf16x8 vf;
            vf = (bf16x8){ta0[0], ta0[1], ta0[2], ta0[3], tb0[0], tb0[1], tb0[2], tb0[3]}; o[0] = __builtin_amdgcn_mfma_f32_16x16x32_bf16(vf, pf0.v, o[0], 0, 0, 0);
            vf = (bf16x8){ta1[0], ta1[1], ta1[2], ta1[3], tb1[0], tb1[1], tb1[2], tb1[3]}; o[1] = __builtin_amdgcn_mfma_f32_16x16x32_bf16(vf, pf0.v, o[1], 0, 0, 0);
            vf = (bf16x8){ta2[0], ta2[1], ta2[2], ta2[3], tb2[0], tb2[1], tb2[2], tb2[3]}; o[2] = __builtin_amdgcn_mfma_f32_16x16x32_bf16(vf, pf0.v, o[2], 0, 0, 0);
            vf = (bf16x8){ta3[0], ta3[1], ta3[2], ta3[3], tb3[0], tb3[1], tb3[2], tb3[3]}; o[3] = __builtin_amdgcn_mfma_f32_16x16x32_bf16(vf, pf0.v, o[3], 0, 0, 0);
            vf = (bf16x8){ua0[0], ua0[1], ua0[2], ua0[3], ub0[0], ub0[1], ub0[2], ub0[3]}; o[0] = __builtin_amdgcn_mfma_f32_16x16x32_bf16(vf, pf1.v, o[0], 0, 0, 0);
            vf = (bf16x8){ua1[0], ua1[1], ua1[2], ua1[3], ub1[0], ub1[1], ub1[2], ub1[3]}; o[1] = __builtin_amdgcn_mfma_f32_16x16x32_bf16(vf, pf1.v, o[1], 0, 0, 0);
            vf = (bf16x8){ua2[0], ua2[1], ua2[2], ua2[3], ub2[0], ub2[1], ub2[2], ub2[3]}; o[2] = __builtin_amdgcn_mfma_f32_16x16x32_bf16(vf, pf1.v, o[2], 0, 0, 0);
            vf = (bf16x8){ua3[0], ua3[1], ua3[2], ua3[3], ub3[0], ub3[1], ub3[2], ub3[3]}; o[3] = __builtin_amdgcn_mfma_f32_16x16x32_bf16(vf, pf1.v, o[3], 0, 0, 0);
        }
        const float inv = 1.0f / sum;
#pragma unroll
        for (int dt = 0; dt < 4; ++dt) { u32x2 w; w.x = cvt_pk_bf16(o[dt][0] * inv, o[dt][1] * inv); w.y = cvt_pk_bf16(o[dt][2] * inv, o[dt][3] * inv);
            *(LAS u32x2*)(vt + fr * 144 + (16 * dt + 4 * fq) * 2) = w; }
        { const u32x4 o0 = *(const LAS u32x4*)(vt + (lane >> 3) * 144 + (lane & 7) * 16), o1 = *(const LAS u32x4*)(vt + ((lane >> 3) + 8) * 144 + (lane & 7) * 16);
          bf16_t* od = O + ((size_t)b * SEQL + r * 64 + 16 * qt + (lane >> 3)) * 1024 + h * 64 + (lane & 7) * 8;
          *(u32x4*)od = o0; *(u32x4*)(od + (size_t)8 * 1024) = o1;
          asm volatile("s_waitcnt lgkmcnt(0)" ::: "memory"); }
    }
}
#ifndef EN_SETUP
#define EN_SETUP 1
#endif
#ifndef EN_EVEN
#define EN_EVEN 1
#endif
#ifndef EN_ODD
#define EN_ODD 1
#endif
#ifndef EN_ATT
#define EN_ATT 1
#endif
#ifndef DUP_ROW
#define DUP_ROW 1
#endif
#ifndef DUP_ATT
#define DUP_ATT 1
#endif
#ifndef DUP_PC
#define DUP_PC 1
#endif
#ifndef DUP_FFN
#define DUP_FFN 1
#endif
#ifndef DUP_MIX
#define DUP_MIX 1
#endif
#ifndef DUP_P0
#define DUP_P0 1
#endif
#define GEMM_SP2 true
#define GEMM_ALIGN true
__global__ void __launch_bounds__(NTHR, 2) fwd_megakernel(Args kargs) {
    extern __shared__ __attribute__((aligned(16))) unsigned char lds_raw[];
    LAS unsigned char* lds = (LAS unsigned char*)lds_raw;
    cg::grid_group grid = cg::this_grid();
    const int G = gridDim.x, bx = blockIdx.x, NGW = G * NWAV, NGT = G * NTHR;
    const int lo = kargs.ph_lo, hi = kargs.ph_hi; int ph = 0;
    volatile LAS unsigned* xst = (volatile LAS unsigned*)(lds + 131072 + 8128);
    if (threadIdx.x < 2) xst[threadIdx.x] = 0u;
    __syncthreads();
    const XcdBarrier xbar = xcd_barrier_post((unsigned*)(kargs.ws + WS_BAR), xst);
#define PH_BEGIN if (ph >= lo && ph < hi) { ArgsP a = args_ptr(); int tid = threadIdx.x; asm volatile("" : "+v"(tid)); const int lane = tid & 63, wave = __builtin_amdgcn_readfirstlane(tid >> 6), gw = bx * NWAV + wave, gt = bx * NTHR + tid; \
    unsigned char* ws = a->ws; bf16_t* HB = (bf16_t*)(ws + WS_XN); bf16_t* SCR = (bf16_t*)a->out; float* RS = (float*)(ws + WS_RS); bf16_t* FB = (bf16_t*)(ws + WS_F); bf16_t* BIG = (bf16_t*)(ws + WS_BIG); bf16_t* ZS = (bf16_t*)(ws + WS_ZS); float* SLOC = (float*)(ws + WS_SLOC); bf16_t* YG = (bf16_t*)(ws + WS_YG); \
    (void)lane; (void)wave; (void)gw; (void)gt; (void)HB; (void)SCR; (void)RS; (void)FB; (void)BIG; (void)ZS; (void)SLOC; (void)YG;
#ifndef DUP_SYNC
#define DUP_SYNC 1
#endif
#define PH_END } { const bool seam = (ph >= lo && ph + 1 < hi); ++ph; if (seam) for (int rs = 0; rs < DUP_SYNC; ++rs) { if (ph == 2) grid.sync(); else xcd_barrier(xbar); } }

    PH_BEGIN
        ssm_tables0(a, gt, NGT);
    PH_END
    PH_BEGIN
      for (int rep = 0; rep < DUP_P0; ++rep) {
#if EN_SETUP
        ssm_tables1(a, gt, NGT);
        attn_table(a, gt, NGT);
        wcat_fold(a, gt, NGT);
        transposes_phase(a, (LAS float*)(lds + wave * 8448), gw, NGW, lane);
#endif
        rowwise_phase(a->x, HB, nullptr, nullptr, 0.f, RS, nullptr, gw, NGW, lane);
      }
    PH_END

#pragma nounroll
    for (int layer = 0; layer < 4; ++layer) {
        const int mi = layer >> 1;
#pragma nounroll
        for (int half = 0; half < 2; ++half) {
            if (half == 1) {
                if ((layer & 1) == 0) {
#if EN_EVEN
                    PH_BEGIN
                        pg8::Gemm g{HB, (const bf16_t*)(ws + WS_WIN) + (size_t)mi * DM * DM, MTOK, DM, DM, DM, DM, 0, 0}; pg8::StaticOrder S; S.init(MTOK, DM, G, bx);
                        LAS float* rsl = (LAS float*)(lds + 131072); rsl_fill(rsl, RS, bx, tid);
                        EpiZ E{FB, ZS, rsl};
                        for (int rep = 0; rep < DUP_MIX; ++rep) { pg8::gemm_phase<EpiZ, pg8::StaticOrder, GEMM_ALIGN, GEMM_SP2>(lds, g, S, E); }
                    PH_END
                    PH_BEGIN
                        for (int rep = 0; rep < DUP_PC; ++rep) pool_phase(FB, SCR, gw, NGW, lane);
                        pg8::Gemm g{ZS, (const bf16_t*)(ws + WS_WST + (size_t)mi * 32 * SZ_WST), NCHUNK, 256, 512, 768, 512, (size_t)NCHUNK * 768 * 2, SZ_WST}; BatchOrder S; S.init(NCHUNK, 256, 32, G, bx);
                        EpiState E{SLOC};
                        for (int rep = 0; rep < DUP_MIX; ++rep) { pg8::gemm_phase<EpiState, BatchOrder, GEMM_ALIGN, GEMM_SP2>(lds, g, S, E); }
                    PH_END
                    PH_BEGIN
                        for (int rep = 0; rep < DUP_PC; ++rep) { carry_phase(a, mi, wave, lane, G); }
                        if (layer == 0) ssm_tables2(a, gt, NGT);
                    PH_END
                    PH_BEGIN
                        pg8::Gemm g{ZS, (const bf16_t*)(ws + WS_MTOEP + (size_t)mi * 32 * SZ_MTOEP), NCHUNK, 512, 768, 768, 768, (size_t)NCHUNK * 768 * 2, SZ_MTOEP}; BatchOrder S; S.init(NCHUNK, 512, 32, G, bx);
                        EpiSsmOut E{YG};
                        for (int rep = 0; rep < DUP_MIX; ++rep) { pg8::gemm_phase<EpiSsmOut, BatchOrder, GEMM_ALIGN, GEMM_SP2>(lds, g, S, E); }
                    PH_END
                    PH_BEGIN
                        pg8::Gemm g{YG, (const bf16_t*)(ws + WS_WGLU) + (size_t)mi * 512 * 512, MTOK, 512, 512, 512, 512, 0, 0}; pg8::StaticOrder S; S.init(MTOK, 512, G, bx);
                        EpiGlu E{YG, a->b_glu + mi * 512, SCR};
                        for (int rep = 0; rep < DUP_MIX; ++rep) { pg8::gemm_phase<EpiGlu, pg8::StaticOrder, GEMM_ALIGN, GEMM_SP2>(lds, g, S, E); }
                    PH_END
                    PH_BEGIN
                        pg8::Gemm g{SCR, (const bf16_t*)(ws + WS_WCAT) + (size_t)mi * DM * DM, MTOK, DM, DM, DM, DM, 0, 0};
                        pg8::StaticOrder S; S.init(MTOK, DM, G, bx);
                        EpiResNorm E{HB, a->norm_g + (size_t)layer * 6 * DM + 3 * DM, 1.0f, (float*)(ws + WS_XS), RS, (unsigned*)(ws + WS_PCNT), 4u * (unsigned)(3 * layer + 2), nullptr, lds + 131072};
                        pg8::gemm_phase<EpiResNorm, pg8::StaticOrder, true, GEMM_SP2>(lds, g, S, E);
                    PH_END
#endif
                } else {
#if EN_ODD
                    PH_BEGIN
                        pg8::Gemm g{HB, (const bf16_t*)(ws + WS_WQKV) + (size_t)mi * 3072 * DM, MTOK, 3072, DM, DM, DM, 0, 0}; pg8::StaticOrder S; S.init(MTOK, 3072, G, bx);
                        LAS float* rsl = (LAS float*)(lds + 131072); rsl_fill(rsl, RS, bx, tid);
                        EpiQKV E{BIG, rsl};
                        for (int rep = 0; rep < DUP_MIX; ++rep) { pg8::gemm_phase<EpiQKV, pg8::StaticOrder, GEMM_ALIGN, GEMM_SP2>(lds, g, S, E); }
                    PH_END
                    PH_BEGIN
#if EN_ATT
                        for (int rep = 0; rep < DUP_ATT; ++rep) { attn_phase(lds, BIG, (const float*)(ws + WS_ATB) + (size_t)mi * 2097152, SCR, tid, wave, lane, G); }
#endif
                        __syncthreads();
                    PH_END
                    PH_BEGIN
                        pg8::Gemm g{SCR, (const bf16_t*)(ws + WS_WO) + (size_t)mi * DM * DM, MTOK, DM, DM, DM, DM, 0, 0};
                        pg8::StaticOrder S; S.init(MTOK, DM, G, bx);
                        EpiResNorm E{HB, a->norm_g + (size_t)layer * 6 * DM + 3 * DM, 1.0f, (float*)(ws + WS_XS), RS, (unsigned*)(ws + WS_PCNT), 4u * (unsigned)(3 * layer + 2), nullptr, lds + 131072};
                        pg8::gemm_phase<EpiResNorm, pg8::StaticOrder, true, GEMM_SP2>(lds, g, S, E);
                    PH_END
#endif
                }
            }
            const int f = layer * 2 + half;
            PH_BEGIN
                pg8::Gemm g{HB, (const bf16_t*)(ws + WS_WGU + (size_t)f * SZ_WGU), MTOK, 2 * DFF, DM, DM, DM, 0, 0}; pg8::StaticOrder S; S.init(MTOK, 2 * DFF, G, bx);
                LAS float* rsl = (LAS float*)(lds + 131072);
                { const int nwg = 256 * 22, q8 = nwg / 8, wg0 = (bx % 8) * q8 + bx / 8, off = (wg0 % 176) % 8;
#pragma unroll
                  for (int k = 0; k < 4; ++k) { const int pmk = 8 * ((bx % 8) * 4 + k) + off; if (tid < 256) rsl[k * 256 + tid] = row_rs(RS, pmk * 256 + tid); } }
                __syncthreads();
                EpiSwiglu E{BIG, rsl};
                for (int rep = 0; rep < DUP_FFN; ++rep) pg8::gemm_phase<EpiSwiglu, pg8::StaticOrder, GEMM_ALIGN, GEMM_SP2>(lds, g, S, E);
            PH_END
            PH_BEGIN
                pg8::Gemm g{BIG, (const bf16_t*)(ws + WS_WD + (size_t)f * SZ_WD), MTOK, DM, DFF, DFF, DFF, 0, 0};
                pg8::StaticOrder S; S.init(MTOK, DM, G, bx);
                EpiResNorm E{HB, a->norm_g + (size_t)layer * 6 * DM + (half == 0 ? 1 : 5) * DM, 0.5f, (float*)(ws + WS_XS), RS, (unsigned*)(ws + WS_PCNT), 4u * (unsigned)(3 * layer + (half == 0 ? 1 : 3)), (layer == 3 && half == 1) ? a->out : nullptr, lds + 131072};
                pg8::gemm_phase<EpiResNorm, pg8::StaticOrder, true, GEMM_SP2>(lds, g, S, E);
            PH_END
        }
    }
}

extern "C" void kernel_launch(void* const* d_in, const int* in_sizes, int n_in, void* d_out, int out_size, void* d_ws, size_t ws_size, hipStream_t stream) {
    static int grid = 0;
    if (grid == 0) {
        if (n_in != 22 || out_size != MTOK * DM || ws_size < WS_END) { fprintf(stderr, "kernel_launch: unexpected problem (n_in %d, out %d, ws %zu, need %zu)\n", n_in, out_size, ws_size, (size_t)WS_END); grid = -1; return; }
        int dev = 0, cus = 0, per_cu = 0;
        hipGetDevice(&dev); hipDeviceGetAttribute(&cus, hipDeviceAttributeMultiprocessorCount, dev);
        if (hipFuncSetAttribute((const void*)fwd_megakernel, hipFuncAttributeMaxDynamicSharedMemorySize, LDS_BYTES) != hipSuccess) { fprintf(stderr, "kernel_launch: hipFuncSetAttribute failed\n"); }
        if (hipOccupancyMaxActiveBlocksPerMultiprocessor(&per_cu, (const void*)fwd_megakernel, NTHR, LDS_BYTES) != hipSuccess || per_cu < 1) { fprintf(stderr, "kernel_launch: occupancy query says %d blocks/CU; using 1\n", per_cu); per_cu = 1; }
        (void)hipGetLastError();
        grid = cus * 1;
        if (per_cu < 1) grid = -1;
    }
    if (grid < 0) return;
    Args a{};
    a.x = (const float*)d_in[0]; a.norm_g = (const float*)d_in[1]; a.w_gate = (const float*)d_in[2]; a.w_up = (const float*)d_in[3]; a.w_down = (const float*)d_in[4];
    a.ab_w_in = (const float*)d_in[5]; a.pool_w = (const float*)d_in[6]; a.pool_scale = (const float*)d_in[7]; a.A_re = (const float*)d_in[8]; a.A_im = (const float*)d_in[9];
    a.log_dt = (const float*)d_in[10]; a.B_re = (const float*)d_in[11]; a.B_im = (const float*)d_in[12]; a.C_re = (const float*)d_in[13]; a.C_im = (const float*)d_in[14];
    a.ssm_D = (const float*)d_in[15]; a.w_glu = (const float*)d_in[16]; a.b_glu = (const float*)d_in[17]; a.ab_w_out = (const float*)d_in[18]; a.w_qkv = (const float*)d_in[19];
    a.rpb = (const float*)d_in[20]; a.na_w_out = (const float*)d_in[21];
    a.out = (float*)d_out; a.ws = (unsigned char*)d_ws; a.ph_lo = 0; a.ph_hi = 1 << 20;
    if (hipMemsetAsync((unsigned char*)d_ws + WS_BAR, 0, BAR_BYTES, stream) != hipSuccess) { fprintf(stderr, "kernel_launch: memset of barrier words failed\n"); return; }
    void* args[] = {&a};
    hipError_t e = hipLaunchCooperativeKernel((const void*)fwd_megakernel, dim3(grid), dim3(NTHR), args, LDS_BYTES, stream);
    if (e != hipSuccess) fprintf(stderr, "kernel_launch: cooperative launch failed: %s (grid %d)\n", hipGetErrorString(e), grid);
}
```

```cpp
#include <hip/hip_runtime.h>
#include <hip/hip_cooperative_groups.h>
#include <cstdio>
#include <cstdint>
namespace cg = cooperative_groups;
namespace pg8 {
#define PG8_LAS __attribute__((address_space(3)))
typedef unsigned short bf16_t;
typedef short bf16x8 __attribute__((ext_vector_type(8)));
typedef float f32x4 __attribute__((ext_vector_type(4)));
typedef unsigned u32x4 __attribute__((ext_vector_type(4)));
constexpr int BM = 256, BK = 64, HALF = 128, HTB = HALF * BK * 2  , STAGE_BYTES = 8 * HTB, NXCD = 8, WGM = 8;

__host__ __device__ __forceinline__ int lds_byte(int r, int c) { const int st = (r >> 4) * 2 + (c >> 5), rr = r & 15, cc = c & 31, ob = rr * 64 + cc * 2; return st * 1024 + (ob ^ (((ob >> 9) & 1) << 5)); }
__host__ __device__ __forceinline__ void stage_rc(int b, int& R, int& C) { const int st = b / 1024, sb = b % 1024, swz = sb ^ (((sb >> 9) & 1) << 5); R = (st >> 1) * 16 + swz / 64; C = (st & 1) * 32 + (swz % 64) / 2; }
__host__ __device__ __forceinline__ int perm32(int rho) { const int n = rho >> 4, i = rho & 15; return 8 * (i >> 2) + 4 * n + (i & 3); }

struct Unit { int pm, pn, pb; };
struct Gemm { const bf16_t* A; const bf16_t* Bt; int M, N, K, lda, ldb; size_t sA, sB; };

struct StaticOrder {
    int nM, nN, nwg, G, c;
    __host__ __device__ void init(int M, int N, int G_, int c_) { nM = M / BM; nN = N / BM; nwg = nM * nN; G = G_; c = c_; }
    __host__ __device__ bool next(int i, Unit& u) const {
        const long L = (long)i * G + c; if (L >= nwg) return false;
        int wgid = (int)L; { const int q = nwg / NXCD, r = nwg % NXCD, xcd = wgid % NXCD, off = wgid / NXCD; wgid = (xcd < r ? xcd * (q + 1) : r * (q + 1) + (xcd - r) * q) + off; }
        const int nig = WGM * nN, gid = wgid / nig, fm = gid * WGM, gsz = (nM - fm) < WGM ? (nM - fm) : WGM;
        u.pm = fm + ((wgid % nig) % gsz); u.pn = (wgid % nig) / gsz; u.pb = 0; return true;
    }
    __device__ __forceinline__ void a_ready(const Unit&) const {}
    __device__ __forceinline__ void done(const Unit&) const {}
};


template <class Epi, class Sched, bool ALIGN_EPI = false, bool SP2 = false>
__device__ __forceinline__ void gemm_phase(PG8_LAS unsigned char* lds, const Gemm g, const Sched& S, const Epi& E) {
    int tid_ = threadIdx.x; asm volatile("" : "+v"(tid_));
    const int tid = tid_, wid = __builtin_amdgcn_readfirstlane(tid >> 6), lane = tid & 63, wr = wid >> 2, wc = wid & 3, fr = lane & 15, fq = lane >> 4;
    const int K = g.K, nt = K / BK;
    unsigned voffA[2], voffB[2];
#pragma unroll
    for (int i = 0; i < 2; ++i) { int R, C; stage_rc(tid * 16 + i * 8192, R, C); const int Rb = Epi::PERM ? ((R & ~31) + perm32(R & 31)) : R;
        voffA[i] = (unsigned)(R * g.lda + C) * 2u; voffB[i] = (unsigned)(Rb * g.ldb + C) * 2u; }
    const size_t kstep = (size_t)(BK * 2);
    const size_t hstepA = (size_t)HALF * g.lda * 2, hstepB = (size_t)HALF * g.ldb * 2;
    const size_t tstepA = 2 * hstepA, tstepB = 2 * hstepB;
    const unsigned ldsw = (unsigned)wid * 1024u;
    const int aoff = lds_byte(wr * 64 + fr, fq * 8), boff = lds_byte(wc * 32 + fr, fq * 8);
#define PG8_SA(b, h) (((b) * 2 + (h)) * HTB)
#define PG8_SB(b, h) ((4 + (b) * 2 + (h)) * HTB)
#define PG8_STAGE(bufoff, gbase, voff) do { _Pragma("unroll") for (int _i = 0; _i < 2; ++_i) \
        __builtin_amdgcn_global_load_lds((const unsigned*)((const char*)(gbase) + (voff)[_i]), (PG8_LAS unsigned*)(lds + (bufoff) + ldsw + _i * 8192), 16, 0, 0); } while (0)
#define PG8_LDA(dst, b, h) do { _Pragma("unroll") for (int m = 0; m < 4; ++m) _Pragma("unroll") for (int k = 0; k < 2; ++k) dst[m][k] = *(const PG8_LAS bf16x8*)(lds + PG8_SA(b, h) + aoff + m * 2048 + k * 1024); } while (0)
#define PG8_LDB(dst, b, h) do { _Pragma("unroll") for (int n = 0; n < 2; ++n) _Pragma("unroll") for (int k = 0; k < 2; ++k) dst[n][k] = *(const PG8_LAS bf16x8*)(lds + PG8_SB(b, h) + boff + n * 2048 + k * 1024); } while (0)
#define PG8_MMA(ai, bj, At, Bt) do { __builtin_amdgcn_s_setprio(1); _Pragma("unroll") for (int m = 0; m < 4; ++m) _Pragma("unroll") for (int n = 0; n < 2; ++n) _Pragma("unroll") for (int k = 0; k < 2; ++k) \
        acc[ai][bj][m][n] = __builtin_amdgcn_mfma_f32_16x16x32_bf16(Bt[n][k], At[m][k], acc[ai][bj][m][n], 0, 0, 0); __builtin_amdgcn_s_setprio(0); } while (0)
#define PG8_WAIT_V(n) asm volatile("s_waitcnt vmcnt(" #n ")" ::: "memory")
#define PG8_WAIT_L(n) asm volatile("s_waitcnt lgkmcnt(" #n ")" ::: "memory")
#define PG8_BAR __builtin_amdgcn_s_barrier()
#define PG8_SCHED __builtin_amdgcn_sched_barrier(0)
    Unit cur, nxt; int ui = 0;
    if (!S.next(0, cur)) return;
    f32x4 acc[2][2][4][2];
#pragma unroll
    for (int a = 0; a < 2; ++a)
#pragma unroll
        for (int b = 0; b < 2; ++b)
#pragma unroll
            for (int m = 0; m < 4; ++m)
#pragma unroll
                for (int n = 0; n < 2; ++n) acc[a][b][m][n] = (f32x4){0.f, 0.f, 0.f, 0.f};
    bf16x8 At[4][2], B0[2][2], B1[2][2];
    const char* cA = (const char*)g.A + (size_t)cur.pm * tstepA + (size_t)cur.pb * g.sA; const char* cB = (const char*)g.Bt + (size_t)cur.pn * tstepB + (size_t)cur.pb * g.sB;
    S.a_ready(cur);
    if constexpr (SP2) {
        PG8_STAGE(PG8_SB(0, 0), cB, voffB); PG8_STAGE(PG8_SB(0, 1), cB + hstepB, voffB); PG8_STAGE(PG8_SA(0, 0), cA, voffA); PG8_STAGE(PG8_SA(0, 1), cA + hstepA, voffA);
        if (wr == 1) PG8_BAR;
        PG8_WAIT_V(2); PG8_BAR;
        PG8_STAGE(PG8_SB(1, 0), cB + kstep, voffB); PG8_STAGE(PG8_SA(1, 0), cA + kstep, voffA); PG8_STAGE(PG8_SB(1, 1), cB + hstepB + kstep, voffB);
        PG8_WAIT_V(6); PG8_BAR;
    } else {
        PG8_STAGE(PG8_SB(0, 0), cB, voffB); PG8_STAGE(PG8_SA(0, 0), cA, voffA); PG8_STAGE(PG8_SB(0, 1), cB + hstepB, voffB); PG8_STAGE(PG8_SA(0, 1), cA + hstepA, voffA);
        if (wr == 1) PG8_BAR;
        PG8_WAIT_V(4); PG8_BAR;
        PG8_STAGE(PG8_SB(1, 0), cB + kstep, voffB); PG8_STAGE(PG8_SA(1, 0), cA + kstep, voffA); PG8_STAGE(PG8_SB(1, 1), cB + hstepB + kstep, voffB);
        PG8_WAIT_V(6); PG8_BAR;
    }
    for (;;) {
        const bool has_next = S.next(ui + 1, nxt);
        const char* nA = has_next ? (const char*)g.A + (size_t)nxt.pm * tstepA + (size_t)nxt.pb * g.sA : cA; const char* nB = has_next ? (const char*)g.Bt + (size_t)nxt.pn * tstepB + (size_t)nxt.pb * g.sB : cB;
        for (int t = 0; t < nt; t += 2) {
            const bool last = (t == nt - 2);
            const char* a1 = cA + (size_t)(t + 1) * kstep;
            const char* a2 = last ? nA : cA + (size_t)(t + 2) * kstep; const char* b2 = last ? nB : cB + (size_t)(t + 2) * kstep;
            const char* a3 = a2 + kstep; const char* b3 = b2 + kstep;
            if (last && has_next) S.a_ready(nxt);
            if constexpr (SP2) {
            PG8_LDB(B0, 0, 0); PG8_LDB(B1, 0, 1); PG8_SCHED; PG8_LDA(At, 0, 0); PG8_STAGE(PG8_SA(1, 1), a1 + hstepA, voffA);
            PG8_WAIT_V(8); PG8_WAIT_L(0); PG8_BAR; PG8_MMA(0, 0, At, B0); PG8_MMA(0, 1, At, B1); PG8_BAR; PG8_SCHED;
            PG8_LDA(At, 0, 1); PG8_STAGE(PG8_SB(0, 0), b2, voffB); PG8_STAGE(PG8_SB(0, 1), b2 + hstepB, voffB); PG8_STAGE(PG8_SA(0, 0), a2, voffA);
            PG8_WAIT_V(8); PG8_WAIT_L(0); PG8_BAR; PG8_MMA(1, 0, At, B0); PG8_MMA(1, 1, At, B1); PG8_BAR; PG8_SCHED;
            PG8_LDB(B0, 1, 0); PG8_LDB(B1, 1, 1); PG8_SCHED; PG8_LDA(At, 1, 0); PG8_STAGE(PG8_SA(0, 1), a2 + hstepA, voffA);
            PG8_WAIT_V(8); PG8_WAIT_L(0); PG8_BAR; PG8_MMA(0, 0, At, B0); PG8_MMA(0, 1, At, B1); PG8_BAR; PG8_SCHED;
            PG8_LDA(At, 1, 1); PG8_STAGE(PG8_SB(1, 0), b3, voffB); PG8_STAGE(PG8_SB(1, 1), b3 + hstepB, voffB); PG8_STAGE(PG8_SA(1, 0), a3, voffA);
            PG8_WAIT_V(8); PG8_WAIT_L(0); PG8_BAR; PG8_MMA(1, 0, At, B0); PG8_MMA(1, 1, At, B1); PG8_BAR; PG8_SCHED;
            } else {
            PG8_LDB(B0, 0, 0); PG8_SCHED; PG8_LDA(At, 0, 0); PG8_STAGE(PG8_SA(1, 1), a1 + hstepA, voffA);
            PG8_WAIT_L(8); PG8_BAR; PG8_WAIT_L(0); PG8_MMA(0, 0, At, B0); PG8_BAR; PG8_SCHED;
            PG8_LDB(B1, 0, 1); PG8_STAGE(PG8_SB(0, 0), b2, voffB);
            PG8_BAR; PG8_WAIT_L(0); PG8_MMA(0, 1, At, B1); PG8_BAR;
            PG8_LDA(At, 0, 1); PG8_STAGE(PG8_SA(0, 0), a2, voffA);
            PG8_BAR; PG8_WAIT_L(0); PG8_MMA(1, 0, At, B0); PG8_BAR; PG8_SCHED;
            PG8_STAGE(PG8_SB(0, 1), b2 + hstepB, voffB);
            PG8_WAIT_V(6); PG8_BAR; PG8_MMA(1, 1, At, B1); PG8_BAR;
            PG8_LDB(B0, 1, 0); PG8_SCHED; PG8_LDA(At, 1, 0); PG8_STAGE(PG8_SA(0, 1), a2 + hstepA, voffA);
            PG8_WAIT_L(8); PG8_BAR; PG8_WAIT_L(0); PG8_MMA(0, 0, At, B0); PG8_BAR; PG8_SCHED;
            PG8_LDB(B1, 1, 1); PG8_STAGE(PG8_SB(1, 0), b3, voffB);
            PG8_BAR; PG8_WAIT_L(0); PG8_MMA(0, 1, At, B1); PG8_BAR;
            PG8_LDA(At, 1, 1); PG8_STAGE(PG8_SA(1, 0), a3, voffA);
            PG8_BAR; PG8_WAIT_L(0); PG8_MMA(1, 0, At, B0); PG8_BAR; PG8_SCHED;
            PG8_STAGE(PG8_SB(1, 1), b3 + hstepB, voffB);
            PG8_WAIT_V(6); PG8_BAR; PG8_MMA(1, 1, At, B1); PG8_BAR;
            }
        }
        if constexpr (ALIGN_EPI) { if (wr == 0) PG8_BAR; }
        if constexpr (!Epi::AFTER_DRAIN) { E(acc, cur, wr, wc, fr, fq); S.done(cur); }
        if (!has_next) break;
#pragma unroll
        for (int a = 0; a < 2; ++a)
#pragma unroll
            for (int b = 0; b < 2; ++b)
#pragma unroll
                for (int m = 0; m < 4; ++m)
#pragma unroll
                    for (int n = 0; n < 2; ++n) acc[a][b][m][n] = (f32x4){0.f, 0.f, 0.f, 0.f};
        cur = nxt; cA = nA; cB = nB; ++ui;
        if constexpr (ALIGN_EPI) { if (wr == 1) PG8_BAR; }
    }
    PG8_WAIT_V(0);
    if constexpr (!ALIGN_EPI) { if (wr == 0) PG8_BAR; }
    PG8_BAR;
    if constexpr (Epi::AFTER_DRAIN) { E.fused(acc, cur, wr, wc, fr, fq, lds, wid, lane); S.done(cur); }
#undef PG8_SA
#undef PG8_SB
#undef PG8_STAGE
#undef PG8_LDA
#undef PG8_LDB
#undef PG8_MMA
#undef PG8_WAIT_V
#undef PG8_WAIT_L
#undef PG8_BAR
#undef PG8_SCHED
}
}
using pg8::bf16_t; using pg8::bf16x8; using pg8::f32x4; using pg8::u32x4; using pg8::Unit;
#define LAS PG8_LAS
typedef unsigned u32x2 __attribute__((ext_vector_type(2)));
typedef short s16x4 __attribute__((ext_vector_type(4)));

constexpr int MTOK = 65536, DM = 1024, DFF = 2816, SEQL = 8192, CT = 32, NCHUNK = MTOK / CT  , NTHR = 512, NWAV = 8;
constexpr float RMS_EPS = 1e-6f;
constexpr size_t MiB = 1024ull * 1024ull;
constexpr size_t WS_XN = 0;
constexpr size_t WS_F = WS_XN + 128 * MiB;
constexpr size_t WS_BIG = WS_F + 128 * MiB;
constexpr size_t WS_ZS = WS_BIG, WS_SLOC = WS_BIG + 96 * MiB, WS_YG = WS_BIG + 160 * MiB;
constexpr size_t WS_WGU = WS_BIG + 384 * MiB;
constexpr size_t SZ_WGU = (size_t)5632 * 1024 * 2;
constexpr size_t WS_WD = WS_WGU + 8 * SZ_WGU;
constexpr size_t SZ_WD = (size_t)1024 * 2816 * 2;
constexpr size_t WS_WIN = WS_WD + 8 * SZ_WD;
constexpr size_t WS_WCAT = WS_WIN + 4 * MiB;
constexpr size_t WS_WGLU = WS_WCAT + 4 * MiB;
constexpr size_t WS_WQKV = WS_WGLU + 1 * MiB;
constexpr size_t WS_WO = WS_WQKV + 12 * MiB;
constexpr size_t WS_MTOEP = WS_WO + 4 * MiB;
constexpr size_t SZ_MTOEP = (size_t)512 * 768 * 2;
constexpr size_t WS_WST = WS_MTOEP + 64 * SZ_MTOEP;
constexpr size_t SZ_WST = (size_t)256 * 512 * 2;
constexpr size_t WS_LAMPOW = WS_WST + 64 * SZ_WST;
constexpr size_t WS_BBAR = WS_LAMPOW + 4 * MiB;
constexpr size_t WS_KTAB = WS_BBAR + 1 * MiB;
constexpr size_t WS_BAR = WS_KTAB + 4 * MiB;
constexpr size_t BAR_BYTES = 16384;
constexpr size_t WS_PCNT = WS_BAR + 14336;
constexpr size_t WS_RS = WS_BAR + BAR_BYTES;
constexpr size_t WS_XS = WS_RS + (size_t)MTOK * 16;
constexpr size_t WS_ATB = WS_XS + (size_t)MTOK * 16;
constexpr size_t WS_END = WS_ATB + 16 * MiB;
constexpr int LDS_BYTES = 131072 + 8192;

struct Args {
    const float *x, *norm_g, *w_gate, *w_up, *w_down, *ab_w_in, *pool_w, *pool_scale, *A_re, *A_im, *log_dt, *B_re, *B_im, *C_re, *C_im, *ssm_D, *w_glu, *b_glu, *ab_w_out, *w_qkv, *rpb, *na_w_out;
    float* out; unsigned char* ws; int ph_lo, ph_hi;
};

typedef const Args __attribute__((address_space(4)))* ArgsP;
__device__ __forceinline__ ArgsP args_ptr() { unsigned long long v = (unsigned long long)__builtin_amdgcn_kernarg_segment_ptr(); asm volatile("" : "+s"(v)); return (ArgsP)v; }
__device__ __forceinline__ unsigned cvt_pk_bf16(float lo, float hi) { unsigned r; asm volatile("v_cvt_pk_bf16_f32 %0, %1, %2" : "=v"(r) : "v"(lo), "v"(hi)); return r; }
__device__ __forceinline__ float bf_lo(unsigned w) { return __uint_as_float(w << 16); }
__device__ __forceinline__ float bf_hi(unsigned w) { return __uint_as_float(w & 0xffff0000u); }
__device__ __forceinline__ u32x4 pack8(const f32x4 a, const f32x4 b) { u32x4 w; w.x = cvt_pk_bf16(a[0], a[1]); w.y = cvt_pk_bf16(a[2], a[3]); w.z = cvt_pk_bf16(b[0], b[1]); w.w = cvt_pk_bf16(b[2], b[3]); return w; }
__device__ __forceinline__ float sigmoidf_(float v) { return __builtin_amdgcn_rcpf(1.0f + __builtin_amdgcn_exp2f(-1.4426950408889634f * v)); }
__device__ __forceinline__ float gelu_tanh(float v) { const float u = (1.5957691216057308f * 1.4426950408889634f) * (v + 0.044715f * v * v * v); return v * __builtin_amdgcn_rcpf(1.0f + __builtin_amdgcn_exp2f(-u)); }
__device__ __forceinline__ float wave_sum(float v) {
#pragma unroll
    for (int o = 1; o < 64; o <<= 1) v += __shfl_xor(v, o);
    return v;
}

#define XB_TMO      128
#define XB_XCNT(j)  (256  + 64 * (j))
#define XB_XSUB(j)  (1280 + 64 * (j))
#define XB_XGEN(j)  (2304 + 64 * (j))
#define XB_TOP      3328
#define XB_TOPGEN   3392
#define XCD_BAR_WORDS 3456
#define XB_SPIN_CAP (1u << 18)

__device__ __forceinline__ unsigned xb_ld(unsigned* p)              { return __hip_atomic_load(p, __ATOMIC_RELAXED, __HIP_MEMORY_SCOPE_AGENT); }
__device__ __forceinline__ unsigned xb_add(unsigned* p, unsigned v) { return __hip_atomic_fetch_add(p, v, __ATOMIC_RELAXED, __HIP_MEMORY_SCOPE_AGENT); }
__device__ __forceinline__ unsigned xb_xcc_id() { return (unsigned)__builtin_amdgcn_s_getreg((3 << 11) | 20) & 0xFu; }
#define XB_SPIN(cond, bar) do { unsigned _sp = 0; while (cond) { __builtin_amdgcn_s_sleep(1); \
    if ((++_sp & 255u) == 0u) { if (xb_ld(&(bar)[XB_TMO])) break; if (_sp > XB_SPIN_CAP) { atomicAdd(&(bar)[XB_TMO], 1u); break; } } } } while (0)

struct XcdBarrier {
    unsigned* bar; unsigned x;
    volatile LAS unsigned* st;
};

__device__ __forceinline__ XcdBarrier xcd_barrier_post(unsigned* bar, volatile LAS unsigned* st) {
    XcdBarrier b; b.bar = bar; b.x = xb_xcc_id(); b.st = st;
    if (threadIdx.x == 0) (void)xb_add(&bar[XB_XCNT(b.x)], 1u);
    return b;
}
__device__ __forceinline__ void xcd_barrier_complete(unsigned* bar, unsigned x, unsigned& nloc, unsigned& nx) {
    const unsigned G = gridDim.x * gridDim.y * gridDim.z;
    unsigned sum, cnt, mine, sp = 0u;
    for (;;) {
        sum = 0u; cnt = 0u; mine = 0u;
#pragma unroll
        for (unsigned j = 0; j < 16; ++j) { const unsigned c = xb_ld(&bar[XB_XCNT(j)]); sum += c; cnt += (c > 0u) ? 1u : 0u; mine = (j == x) ? c : mine; }
        if (sum == G) break;
        __builtin_amdgcn_s_sleep(1);
        if ((++sp & 255u) == 0u) { if (xb_ld(&bar[XB_TMO])) break; if (sp > XB_SPIN_CAP) { atomicAdd(&bar[XB_TMO], 1u); break; } }
    }
    nloc = mine > 0u ? mine : 1u; nx = cnt > 0u ? cnt : 1u;
}

__device__ __forceinline__ void xcd_barrier(const XcdBarrier& b) {
    asm volatile("s_waitcnt vmcnt(0)" ::: "memory");
    __syncthreads();
    if (threadIdx.x == 0) {
        unsigned* bar = b.bar;
        __builtin_amdgcn_s_waitcnt(0);
        unsigned nloc = b.st[0], nx = b.st[1];
        if (nloc == 0u) { xcd_barrier_complete(bar, b.x, nloc, nx); b.st[0] = nloc; b.st[1] = nx; }
        const unsigned old = xb_add(&bar[XB_XSUB(b.x)], 1u);
        const unsigned gen = old / nloc;
        if (old + 1u == (gen + 1u) * nloc) {
            __builtin_amdgcn_fence(__ATOMIC_RELEASE, "agent");
            asm volatile("s_waitcnt vmcnt(0)" ::: "memory");
            const unsigned og = xb_add(&bar[XB_TOP], 1u);
            const unsigned tg = og / nx;
            if (og + 1u == (tg + 1u) * nx) xb_add(&bar[XB_TOPGEN], 1u);
            else XB_SPIN(xb_ld(&bar[XB_TOPGEN]) == tg, bar);
            __builtin_amdgcn_fence(__ATOMIC_ACQUIRE, "agent");
            xb_add(&bar[XB_XGEN(b.x)], 1u);
            asm volatile("s_waitcnt vmcnt(0)" ::: "memory");
        } else {
            XB_SPIN(xb_ld(&bar[XB_XGEN(b.x)]) == gen, bar);
            __builtin_amdgcn_fence(__ATOMIC_ACQUIRE, "agent");
            asm volatile("s_waitcnt vmcnt(0)" ::: "memory");
        }
    }
    __syncthreads();
}

__device__ __forceinline__ void unpack8(const u32x4 w, float (&v)[8]) { v[0] = bf_lo(w.x); v[1] = bf_hi(w.x); v[2] = bf_lo(w.y); v[3] = bf_hi(w.y); v[4] = bf_lo(w.z); v[5] = bf_hi(w.z); v[6] = bf_lo(w.w); v[7] = bf_hi(w.w); }
__device__ __forceinline__ float row_rs(const float* RSP, int row) { const f32x4 p = *(const f32x4*)(RSP + (size_t)row * 4); return rsqrtf(((p[0] + p[1]) + (p[2] + p[3])) * (1.0f / DM) + RMS_EPS); }
__device__ __forceinline__ void row_rs8(const float* RSP, int row0, float (&rs)[2][4]) {
    f32x4 p[2][4];
#pragma unroll
    for (int ai = 0; ai < 2; ++ai)
#pragma unroll
        for (int m = 0; m < 4; ++m) p[ai][m] = *(const f32x4*)(RSP + (size_t)(row0 + ai * 128 + m * 16) * 4);
#pragma unroll
    for (int ai = 0; ai < 2; ++ai)
#pragma unroll
        for (int m = 0; m < 4; ++m) rs[ai][m] = rsqrtf(((p[ai][m][0] + p[ai][m][1]) + (p[ai][m][2] + p[ai][m][3])) * (1.0f / DM) + RMS_EPS);
    asm volatile("" : "+v"(rs[0][0]), "+v"(rs[0][1]), "+v"(rs[0][2]), "+v"(rs[0][3]), "+v"(rs[1][0]), "+v"(rs[1][1]), "+v"(rs[1][2]), "+v"(rs[1][3]));
}
__device__ __forceinline__ void rsl_fill(LAS float* rsl, const float* RSP, int bx, int tid) {
#pragma unroll
    for (int k = 0; k < 4; ++k) { const int pmk = 8 * ((bx % 8) * 4 + k) + ((bx / 8) % 8); if (tid < 256) rsl[k * 256 + tid] = row_rs(RSP, pmk * 256 + tid); }
    __syncthreads();
}
__device__ __forceinline__ void rsl_read(const LAS float* RSL, int pm, int wr, int fr, float (&rs)[2][4]) {
    int frl = fr; asm volatile("" : "+v"(frl));
    const LAS float* t = RSL + ((pm >> 3) & 3) * 256 + wr * 64 + frl;
#pragma unroll
    for (int ai = 0; ai < 2; ++ai)
#pragma unroll
        for (int m = 0; m < 4; ++m) rs[ai][m] = t[ai * 128 + m * 16];
}
struct EpiPlain {
    static constexpr bool PERM = true, AFTER_DRAIN = false;
    bf16_t* O; int ldc; const float* RS;
    __device__ __forceinline__ void operator()(const f32x4 (&acc)[2][2][4][2], const Unit& u, int wr, int wc, int fr, int fq) const {
        const int row0 = u.pm * 256 + wr * 64 + fr, col0 = u.pn * 256 + wc * 32 + 8 * fq;
        float rsv[2][4];
        if (RS) row_rs8(RS, row0, rsv);
#pragma unroll
        for (int ai = 0; ai < 2; ++ai)
#pragma unroll
            for (int m = 0; m < 4; ++m) { const int row = row0 + ai * 128 + m * 16; bf16_t* rowp = O + (size_t)row * ldc + col0; const float rs = RS ? rsv[ai][m] : 1.0f;
#pragma unroll
                for (int bj = 0; bj < 2; ++bj) *(u32x4*)(rowp + bj * 128) = pack8(acc[ai][bj][m][0] * rs, acc[ai][bj][m][1] * rs); }
    }
};
struct EpiQKV {
    static constexpr bool PERM = true, AFTER_DRAIN = false;
    bf16_t* O; const LAS float* RSL;
    __device__ __forceinline__ void operator()(const f32x4 (&acc)[2][2][4][2], const Unit& u, int wr, int wc, int fr, int fq) const {
        const int row0 = u.pm * 256 + wr * 64 + fr;
        float rsv[2][4]; rsl_read(RSL, u.pm, wr, fr, rsv);
#pragma unroll
        for (int ai = 0; ai < 2; ++ai)
#pragma unroll
            for (int m = 0; m < 4; ++m) { const int row = row0 + ai * 128 + m * 16, b = row >> 13, t = row & (SEQL - 1); const float rs = rsv[ai][m];
#pragma unroll
                for (int bj = 0; bj < 2; ++bj) { const int col = u.pn * 256 + bj * 128 + wc * 32 + 8 * fq, which = col >> 10, hc = col & 1023, h = hc >> 6, dd = hc & 63;
                    __builtin_nontemporal_store(pack8(acc[ai][bj][m][0] * rs, acc[ai][bj][m][1] * rs), (u32x4*)(O + (size_t)which * ((size_t)MTOK * DM) + ((size_t)(b * 16 + h) * SEQL + t) * 64 + dd)); } }
    }
};
struct EpiSwiglu {
    static constexpr bool PERM = true, AFTER_DRAIN = false;
    bf16_t* O; const LAS float* RSL;
    __device__ __forceinline__ void operator()(const f32x4 (&acc)[2][2][4][2], const Unit& u, int wr, int wc, int fr, int fq) const {
        const int row0 = u.pm * 256 + wr * 64 + fr, col0 = u.pn * 128 + wc * 32 + 8 * fq;
        float rsv[2][4]; { int frl = fr; asm volatile("" : "+v"(frl));
            const LAS float* t = RSL + ((u.pm >> 3) & 3) * 256 + wr * 64 + frl;
#pragma unroll
            for (int ai = 0; ai < 2; ++ai)
#pragma unroll
                for (int m = 0; m < 4; ++m) rsv[ai][m] = t[ai * 128 + m * 16]; }
#pragma unroll
        for (int ai = 0; ai < 2; ++ai)
#pragma unroll
            for (int m = 0; m < 4; ++m) { f32x4 v[2]; const float rs = rsv[ai][m], rsl = rs * -1.4426950408889634f, rs2 = rs * rs;
#pragma unroll
                for (int n = 0; n < 2; ++n) {
                    const f32x4 gt = acc[ai][0][m][n], up = acc[ai][1][m][n]; const f32x4 pr = gt * up, ar = gt * rsl; f32x4 ex;
#pragma unroll
                    for (int e = 0; e < 4; ++e) ex[e] = __builtin_amdgcn_exp2f(ar[e]);
                    const f32x4 dn = ex + 1.0f; f32x4 rc;
#pragma unroll
                    for (int e = 0; e < 4; ++e) rc[e] = __builtin_amdgcn_rcpf(dn[e]);
                    v[n] = (pr * rs2) * rc; }
                __builtin_nontemporal_store(pack8(v[0], v[1]), (u32x4*)(O + (size_t)(row0 + ai * 128 + m * 16) * DFF + col0)); }
    }
};
struct EpiZ {
    static constexpr bool PERM = true, AFTER_DRAIN = false;
    bf16_t* ZP; bf16_t* ZS; const LAS float* RSL;
    __device__ __forceinline__ void operator()(const f32x4 (&acc)[2][2][4][2], const Unit& u, int wr, int wc, int fr, int fq) const {
        const int row0 = u.pm * 256 + wr * 64 + fr;
        float rsv[2][4]; rsl_read(RSL, u.pm, wr, fr, rsv);
#pragma unroll
        for (int ai = 0; ai < 2; ++ai)
#pragma unroll
            for (int m = 0; m < 4; ++m) { const int row = row0 + ai * 128 + m * 16; const float rs = rsv[ai][m];
#pragma unroll
                for (int bj = 0; bj < 2; ++bj) { const int col = u.pn * 256 + bj * 128 + wc * 32 + 8 * fq; const u32x4 w = pack8(acc[ai][bj][m][0] * rs, acc[ai][bj][m][1] * rs);
                    if (u.pn < 2) *(u32x4*)(ZP + (size_t)row * 512 + col) = w;
                    else { const int cs = col - 512, g = cs >> 4, h0 = cs & 15; *(u32x4*)(ZS + ((size_t)g * NCHUNK + (row >> 5)) * 768 + (row & 31) * 16 + h0) = w; } } }
    }
};
struct EpiState {
    static constexpr bool PERM = true, AFTER_DRAIN = false;
    float* S;
    __device__ __forceinline__ void operator()(const f32x4 (&acc)[2][2][4][2], const Unit& u, int wr, int wc, int fr, int fq) const {
        const int row0 = u.pm * 256 + wr * 64 + fr, col0 = wc * 32 + 8 * fq;
#pragma unroll
        for (int ai = 0; ai < 2; ++ai)
#pragma unroll
            for (int m = 0; m < 4; ++m) { float* rowp = S + ((size_t)u.pb * NCHUNK + row0 + ai * 128 + m * 16) * 256 + col0;
#pragma unroll
                for (int bj = 0; bj < 2; ++bj) { *(f32x4*)(rowp + bj * 128) = acc[ai][bj][m][0]; *(f32x4*)(rowp + bj * 128 + 4) = acc[ai][bj][m][1]; } }
    }
};
struct EpiSsmOut {
    static constexpr bool PERM = true, AFTER_DRAIN = false;
    bf16_t* YG;
    __device__ __forceinline__ void operator()(const f32x4 (&acc)[2][2][4][2], const Unit& u, int wr, int wc, int fr, int fq) const {
        const int row0 = u.pm * 256 + wr * 64 + fr;
#pragma unroll
        for (int ai = 0; ai < 2; ++ai)
#pragma unroll
            for (int m = 0; m < 4; ++m) { const int crow = row0 + ai * 128 + m * 16;
#pragma unroll
                for (int bj = 0; bj < 2; ++bj) { const int col = u.pn * 256 + bj * 128 + wc * 32 + 8 * fq, t = col >> 4, h0 = col & 15; f32x4 v[2];
#pragma unroll
                    for (int n = 0; n < 2; ++n)
#pragma unroll
                        for (int e = 0; e < 4; ++e) v[n][e] = gelu_tanh(acc[ai][bj][m][n][e]);
                    *(u32x4*)(YG + ((size_t)crow * CT + t) * 512 + u.pb * 16 + h0) = pack8(v[0], v[1]); } }
    }
};
struct EpiGlu {
    static constexpr bool PERM = true, AFTER_DRAIN = false;
    const bf16_t* YG; const float* bias; bf16_t* CAT;
    __device__ __forceinline__ void operator()(const f32x4 (&acc)[2][2][4][2], const Unit& u, int wr, int wc, int fr, int fq) const {
        const int row0 = u.pm * 256 + wr * 64 + fr;
        u32x4 yv[2][2][4]; f32x4 bv[2][2];
#pragma unroll
        for (int bj = 0; bj < 2; ++bj) { const int col = u.pn * 256 + bj * 128 + wc * 32 + 8 * fq; bv[bj][0] = *(const f32x4*)(bias + col); bv[bj][1] = *(const f32x4*)(bias + col + 4);
#pragma unroll
            for (int ai = 0; ai < 2; ++ai)
#pragma unroll
                for (int m = 0; m < 4; ++m) yv[bj][ai][m] = *(const u32x4*)(YG + (size_t)(row0 + ai * 128 + m * 16) * 512 + col); }
        asm volatile("" ::: "memory");
#pragma unroll
        for (int bj = 0; bj < 2; ++bj) { const int col = u.pn * 256 + bj * 128 + wc * 32 + 8 * fq;
#pragma unroll
            for (int ai = 0; ai < 2; ++ai)
#pragma unroll
                for (int m = 0; m < 4; ++m) { const int row = row0 + ai * 128 + m * 16; const u32x4 y = yv[bj][ai][m];
                    f32x4 v0, v1; const f32x4 a0 = acc[ai][bj][m][0] + bv[bj][0], a1 = acc[ai][bj][m][1] + bv[bj][1];
                    v0[0] = bf_lo(y.x) * sigmoidf_(a0[0]); v0[1] = bf_hi(y.x) * sigmoidf_(a0[1]); v0[2] = bf_lo(y.y) * sigmoidf_(a0[2]); v0[3] = bf_hi(y.y) * sigmoidf_(a0[3]);
                    v1[0] = bf_lo(y.z) * sigmoidf_(a1[0]); v1[1] = bf_hi(y.z) * sigmoidf_(a1[1]); v1[2] = bf_lo(y.w) * sigmoidf_(a1[2]); v1[3] = bf_hi(y.w) * sigmoidf_(a1[3]);
                    *(u32x4*)(CAT + (size_t)row * 1024 + 512 + col) = pack8(v0, v1); } }
    }
};

struct EpiResNorm {
    static constexpr bool PERM = true, AFTER_DRAIN = false;
    bf16_t* HB; const float* ga; float alpha; float* XS; float* RSP; unsigned* cnt; unsigned need; float* OUT; LAS unsigned char* misc;
    __device__ __forceinline__ void operator()(const f32x4 (&acc)[2][2][4][2], const Unit& u, int wr, int wc, int fr, int fq) const {
        LAS float* P = (LAS float*)misc; LAS float* S = (LAS float*)(misc + 4096);
        const int tid = threadIdx.x, rloc0 = wr * 64 + fr, colb = u.pn * 256 + wc * 32 + 8 * fq; const size_t grow0 = (size_t)u.pm * 256;
        f32x4 g[2][2];
#pragma unroll
        for (int bj = 0; bj < 2; ++bj) { g[bj][0] = *(const f32x4*)(ga + colb + bj * 128); g[bj][1] = *(const f32x4*)(ga + colb + bj * 128 + 4); }
        u32x4 pre[4][2];
#pragma unroll
        for (int m = 0; m < 4; ++m)
#pragma unroll
            for (int bj = 0; bj < 2; ++bj) pre[m][bj] = *(const u32x4*)(HB + (grow0 + rloc0 + m * 16) * DM + colb + bj * 128);
#pragma unroll
        for (int ai = 0; ai < 2; ++ai)
#pragma unroll
            for (int m = 0; m < 4; ++m) { float q = 0.f;
#pragma unroll
                for (int bj = 0; bj < 2; ++bj)
#pragma unroll
                    for (int n = 0; n < 2; ++n) { const f32x4 x = acc[ai][bj][m][n]; q += (x[0] * x[0] + x[1] * x[1]) + (x[2] * x[2] + x[3] * x[3]); }
                q += __shfl_xor(q, 16); q += __shfl_xor(q, 32);
                if (fq == 0) P[(rloc0 + ai * 128 + m * 16) * 4 + wc] = q; }
        asm volatile("s_waitcnt lgkmcnt(0)" ::: "memory"); __builtin_amdgcn_s_barrier(); asm volatile("" ::: "memory");
        if (tid < 256) { const float tot = (P[tid * 4 + 0] + P[tid * 4 + 1]) + (P[tid * 4 + 2] + P[tid * 4 + 3]);
            __hip_atomic_store((unsigned*)(XS + (grow0 + tid) * 4 + u.pn), __float_as_uint(tot), __ATOMIC_RELAXED, __HIP_MEMORY_SCOPE_AGENT); }
        asm volatile("s_waitcnt vmcnt(0) lgkmcnt(0)" ::: "memory"); __builtin_amdgcn_s_barrier(); asm volatile("" ::: "memory");
        if (tid == 0) { (void)__hip_atomic_fetch_add(cnt + u.pm, 1u, __ATOMIC_RELAXED, __HIP_MEMORY_SCOPE_AGENT); unsigned sp = 0;
            while (__hip_atomic_load(cnt + u.pm, __ATOMIC_RELAXED, __HIP_MEMORY_SCOPE_AGENT) < need) { __builtin_amdgcn_s_sleep(1); if (++sp > (1u << 22)) break; } }
        asm volatile("s_waitcnt vmcnt(0) lgkmcnt(0)" ::: "memory"); __builtin_amdgcn_s_barrier(); asm volatile("" ::: "memory");
        if (tid < 256) { float ss = 0.f;
#pragma unroll
            for (int t = 0; t < 4; ++t) ss += __uint_as_float(__hip_atomic_load((unsigned*)(XS + (grow0 + tid) * 4 + t), __ATOMIC_RELAXED, __HIP_MEMORY_SCOPE_AGENT));
            S[tid] = alpha * rsqrtf(ss * (1.0f / DM) + RMS_EPS); }
        asm volatile("s_waitcnt vmcnt(0) lgkmcnt(0)" ::: "memory"); __builtin_amdgcn_s_barrier(); asm volatile("" ::: "memory");
#pragma unroll
        for (int ai = 0; ai < 2; ++ai)
#pragma unroll
            for (int m = 0; m < 4; ++m) { const int rloc = rloc0 + ai * 128 + m * 16; const float rs = S[rloc]; float q2 = 0.f;
                u32x4 cur[2]; cur[0] = pre[m][0]; cur[1] = pre[m][1];
                if (ai == 0) {
#pragma unroll
                    for (int bj = 0; bj < 2; ++bj) pre[m][bj] = *(const u32x4*)(HB + (grow0 + rloc + 128) * DM + colb + bj * 128); }
#pragma unroll
                for (int bj = 0; bj < 2; ++bj) { float h[8]; unpack8(cur[bj], h);
#pragma unroll
                    for (int e = 0; e < 4; ++e) { h[e] += acc[ai][bj][m][0][e] * g[bj][0][e] * rs; h[4 + e] += acc[ai][bj][m][1][e] * g[bj][1][e] * rs; }
                    if (OUT) { float* op = OUT + (grow0 + rloc) * DM + colb + bj * 128; *(f32x4*)op = (f32x4){h[0], h[1], h[2], h[3]}; *(f32x4*)(op + 4) = (f32x4){h[4], h[5], h[6], h[7]}; }
                    else { u32x4 w; w.x = cvt_pk_bf16(h[0], h[1]); w.y = cvt_pk_bf16(h[2], h[3]); w.z = cvt_pk_bf16(h[4], h[5]); w.w = cvt_pk_bf16(h[6], h[7]);
                        *(u32x4*)(HB + (grow0 + rloc) * DM + colb + bj * 128) = w; float qv[8]; unpack8(w, qv);
#pragma unroll
                        for (int e = 0; e < 8; ++e) q2 += qv[e] * qv[e]; } }
                q2 += __shfl_xor(q2, 16); q2 += __shfl_xor(q2, 32);
                if (fq == 0) P[rloc * 4 + wc] = q2; }
        asm volatile("s_waitcnt lgkmcnt(0)" ::: "memory"); __builtin_amdgcn_s_barrier(); asm volatile("" ::: "memory");
        if (tid < 256 && !OUT) RSP[(grow0 + tid) * 4 + u.pn] = (P[tid * 4 + 0] + P[tid * 4 + 1]) + (P[tid * 4 + 2] + P[tid * 4 + 3]);
        asm volatile("s_waitcnt lgkmcnt(0)" ::: "memory"); __builtin_amdgcn_s_barrier(); asm volatile("" ::: "memory");
    }
};
struct BatchOrder {
    int nM, nN, nB, G, c;
    __device__ void init(int M, int N, int B, int G_, int c_) { nM = M / 256; nN = N / 256; nB = B; G = G_; c = c_; }
    __device__ bool next(int i, Unit& u) const { const int L = i * G + c; if (L >= nM * nN * nB) return false; u.pb = L / (nM * nN); const int r = L % (nM * nN); u.pn = r / nM; u.pm = r % nM; return true; }
    __device__ __forceinline__ void a_ready(const Unit&) const {}
    __device__ __forceinline__ void done(const Unit&) const {}
};
__device__ __forceinline__ void rowwise_phase(const float* X, bf16_t* HB, const bf16_t* F, const float* ga, float alpha, float* RS, float* OUT, int gw, int NGW, int lane) {
    for (int row0 = gw; row0 < MTOK; row0 += 4 * NGW) {
        float h[4][2][8]; u32x4 fw[4][2];
#pragma unroll
        for (int r = 0; r < 4; ++r) { const int row = row0 + r * NGW;
#pragma unroll
            for (int j = 0; j < 2; ++j) {
                if (X) { const f32x4 a0 = __builtin_nontemporal_load((const f32x4*)(X + (size_t)row * DM + 8 * lane + 512 * j)), a1 = __builtin_nontemporal_load((const f32x4*)(X + (size_t)row * DM + 8 * lane + 512 * j + 4));
                    h[r][j][0] = a0[0]; h[r][j][1] = a0[1]; h[r][j][2] = a0[2]; h[r][j][3] = a0[3]; h[r][j][4] = a1[0]; h[r][j][5] = a1[1]; h[r][j][6] = a1[2]; h[r][j][7] = a1[3]; }
                else { const u32x4 w = *(const u32x4*)(HB + (size_t)row * DM + 8 * lane + 512 * j); unpack8(w, h[r][j]); }
                if (F) fw[r][j] = *(const u32x4*)(F + (size_t)row * DM + 8 * lane + 512 * j); } }
#pragma unroll
        for (int r = 0; r < 4; ++r) { const int row = row0 + r * NGW;
            if (F) { float f[2][8]; float ss = 0.f;
#pragma unroll
                for (int j = 0; j < 2; ++j) { unpack8(fw[r][j], f[j]);
#pragma unroll
                    for (int e = 0; e < 8; ++e) ss += f[j][e] * f[j][e]; }
                const float rs = alpha * rsqrtf(wave_sum(ss) * (1.0f / DM) + RMS_EPS);
#pragma unroll
                for (int j = 0; j < 2; ++j) { const f32x4 g0 = *(const f32x4*)(ga + 8 * lane + 512 * j), g1 = *(const f32x4*)(ga + 8 * lane + 512 * j + 4);
#pragma unroll
                    for (int e = 0; e < 4; ++e) { h[r][j][e] += f[j][e] * g0[e] * rs; h[r][j][4 + e] += f[j][4 + e] * g1[e] * rs; } } }
            if (OUT) {
#pragma unroll
                for (int j = 0; j < 2; ++j) { *(f32x4*)(OUT + (size_t)row * DM + 8 * lane + 512 * j) = (f32x4){h[r][j][0], h[r][j][1], h[r][j][2], h[r][j][3]}; *(f32x4*)(OUT + (size_t)row * DM + 8 * lane + 512 * j + 4) = (f32x4){h[r][j][4], h[r][j][5], h[r][j][6], h[r][j][7]}; }
            } else { float ss = 0.f;
#pragma unroll
                for (int j = 0; j < 2; ++j) { u32x4 w; w.x = cvt_pk_bf16(h[r][j][0], h[r][j][1]); w.y = cvt_pk_bf16(h[r][j][2], h[r][j][3]); w.z = cvt_pk_bf16(h[r][j][4], h[r][j][5]); w.w = cvt_pk_bf16(h[r][j][6], h[r][j][7]);
                    *(u32x4*)(HB + (size_t)row * DM + 8 * lane + 512 * j) = w; float q[8]; unpack8(w, q);
#pragma unroll
                    for (int e = 0; e < 8; ++e) ss += q[e] * q[e]; }
                ss = wave_sum(ss); if (lane == 0) *(f32x4*)(RS + (size_t)row * 4) = (f32x4){ss, 0.f, 0.f, 0.f}; }
        }
    }
}

struct TItem { const float* W; bf16_t* WT; const float* gk; int ldw, k0, n0, ldt, orow0; float scale; };
__device__ __forceinline__ TItem titem_decode(ArgsP a, int it) {
    constexpr int I_FFN = 4224, N_FFN = 8 * I_FFN, I_MIX = 2944;
    const float* W; int ldw, nblk, ldt, orow_add = 0, r; bf16_t* WT; float scale = 1.f; bool il = false; const float* gk = nullptr;
    if (it < N_FFN) { const int f = it / I_FFN; r = it % I_FFN; const int which = r / 1408; r = r % 1408; if (which < 2) gk = a->norm_g + (size_t)((f >> 1) * 6 + ((f & 1) ? 4 : 0)) * DM;
        if (which == 0) { W = a->w_gate + (size_t)f * DM * DFF; ldw = DFF; nblk = 88; WT = (bf16_t*)(a->ws + WS_WGU + f * SZ_WGU); ldt = DM; il = true; }
        else if (which == 1) { W = a->w_up + (size_t)f * DM * DFF; ldw = DFF; nblk = 88; WT = (bf16_t*)(a->ws + WS_WGU + f * SZ_WGU); ldt = DM; il = true; orow_add = 128; }
        else { W = a->w_down + (size_t)f * DFF * DM; ldw = DM; nblk = 32; WT = (bf16_t*)(a->ws + WS_WD + f * SZ_WD); ldt = DFF; }
    } else { const int it2 = it - N_FFN, i = it2 / I_MIX; r = it2 % I_MIX;
        if (r < 512) { gk = a->norm_g + (size_t)((2 * i) * 6 + 2) * DM; W = a->ab_w_in + (size_t)i * DM * DM; ldw = DM; nblk = 32; WT = (bf16_t*)(a->ws + WS_WIN) + (size_t)i * DM * DM; ldt = DM; }
        else if (r < 768) { r -= 512; W = a->ab_w_out + (size_t)i * DM * DM + (size_t)512 * DM; ldw = DM; nblk = 32; WT = (bf16_t*)(a->ws + WS_WCAT) + (size_t)i * DM * DM + 512; ldt = DM; }
        else if (r < 896) { r -= 768; W = a->w_glu + (size_t)i * 512 * 512; ldw = 512; nblk = 16; WT = (bf16_t*)(a->ws + WS_WGLU) + (size_t)i * 512 * 512; ldt = 512; }
        else if (r < 2432) { r -= 896; gk = a->norm_g + (size_t)((2 * i + 1) * 6 + 2) * DM; W = a->w_qkv + (size_t)i * DM * 3072; ldw = 3072; nblk = 96; WT = (bf16_t*)(a->ws + WS_WQKV) + (size_t)i * 3072 * DM; ldt = DM; if ((r % 96) < 32) scale = 0.125f * 1.4426950408889634f;     }
        else { r -= 2432; W = a->na_w_out + (size_t)i * DM * DM; ldw = DM; nblk = 32; WT = (bf16_t*)(a->ws + WS_WO) + (size_t)i * DM * DM; ldt = DM; }
    }
    const int kb = r / nblk, nb = r % nblk, n0 = 32 * nb;
    TItem t; t.W = W; t.WT = WT; t.gk = gk; t.ldw = ldw; t.k0 = 64 * kb; t.n0 = n0; t.ldt = ldt; t.orow0 = il ? ((n0 >> 7) * 256 + (n0 & 127) + orow_add) : n0; t.scale = scale; return t;
}
__device__ __forceinline__ void tile_load(const TItem& t, int lane, f32x4 (&v)[8], float (&gm)[8]) {
    const int n4 = lane & 7, kr = lane >> 3;
#pragma unroll
    for (int i = 0; i < 8; ++i) { v[i] = __builtin_nontemporal_load((const f32x4*)(t.W + (size_t)(t.k0 + kr + 8 * i) * t.ldw + t.n0 + 4 * n4));     gm[i] = t.gk ? t.gk[t.k0 + kr + 8 * i] : 1.0f; }
}
__device__ __forceinline__ void tile_store(const TItem& t, int lane, const f32x4 (&v)[8], const float (&gm)[8], LAS float* scr) {
    { const int n4 = lane & 7, kr = lane >> 3;
#pragma unroll
      for (int i = 0; i < 8; ++i) { LAS float* s = scr + (kr + 8 * i) * 33 + 4 * n4; s[0] = v[i][0] * gm[i]; s[1] = v[i][1] * gm[i]; s[2] = v[i][2] * gm[i]; s[3] = v[i][3] * gm[i]; } }
    asm volatile("s_waitcnt lgkmcnt(0)" ::: "memory");
    const int c = lane & 7;
#pragma unroll
    for (int j = 0; j < 4; ++j) { const int n = (lane >> 3) + 8 * j; const LAS float* s = scr + (8 * c) * 33 + n; const float scale = t.scale;
        u32x4 o; o.x = cvt_pk_bf16(s[0 * 33] * scale, s[1 * 33] * scale); o.y = cvt_pk_bf16(s[2 * 33] * scale, s[3 * 33] * scale); o.z = cvt_pk_bf16(s[4 * 33] * scale, s[5 * 33] * scale); o.w = cvt_pk_bf16(s[6 * 33] * scale, s[7 * 33] * scale);
        *(u32x4*)(t.WT + (size_t)(t.orow0 + n) * t.ldt + t.k0 + 8 * c) = o; }
    asm volatile("s_waitcnt lgkmcnt(0)" ::: "memory");
}
__device__ __forceinline__ void transposes_phase(ArgsP a, LAS float* scr, int gw, int NGW, int lane) {
    constexpr int N_ALL = 8 * 4224 + 2 * 2944;
    if (gw >= N_ALL) return;
    TItem cur = titem_decode(a, gw); f32x4 v[8]; float gm[8]; tile_load(cur, lane, v, gm);
    for (int it = gw; it < N_ALL; it += NGW) {
        const int nx = it + NGW; const bool has = nx < N_ALL; TItem nxt = cur; f32x4 vn[8]; float gn[8];
        if (has) { nxt = titem_decode(a, nx); tile_load(nxt, lane, vn, gn); }
        tile_store(cur, lane, v, gm, scr);
        if (has) { cur = nxt;
#pragma unroll
            for (int i = 0; i < 8; ++i) { v[i] = vn[i]; gm[i] = gn[i]; } }
    }
}

__device__ __forceinline__ void ssm_tables0(ArgsP a, int gt, int NGT) {
    float* LP = (float*)(a->ws + WS_LAMPOW); float* BB = (float*)(a->ws + WS_BBAR);
    for (int idx = gt; idx < 8192; idx += NGT) {
        const int q = idx >> 6, p = idx & 63;
        const float are = fminf(a->A_re[idx], -1e-4f), aim = a->A_im[idx], dt = expf(a->log_dt[q]);
        const float mag = expf(are * dt), lr = mag * cosf(aim * dt), li = mag * sinf(aim * dt);
        float pr = 1.f, pi = 0.f;
        for (int tau = 0; tau <= 32; ++tau) { *(float2*)(LP + ((size_t)(q * 33 + tau) * 64 + p) * 2) = make_float2(pr, pi); const float nr = pr * lr - pi * li, ni = pr * li + pi * lr; pr = nr; pi = ni; }
        const float nre = lr - 1.f, nim = li, den = are * are + aim * aim;
        const float fre = (nre * are + nim * aim) / den, fim = (nim * are - nre * aim) / den;
        for (int h = 0; h < 16; ++h) { const float br = a->B_re[(size_t)idx * 16 + h], bi = a->B_im[(size_t)idx * 16 + h];
            *(float2*)(BB + ((size_t)idx * 16 + h) * 2) = make_float2(fre * br - fim * bi, fre * bi + fim * br); }
    }
}
__device__ __forceinline__ void ssm_tables1(ArgsP a, int gt, int NGT) {
    const float2* LP = (const float2*)(a->ws + WS_LAMPOW); const float2* BB = (const float2*)(a->ws + WS_BBAR); float* KT = (float*)(a->ws + WS_KTAB);
    for (int o = gt; o < 128 * 32 * 256; o += NGT) {
        const int hp = o & 15, h = (o >> 4) & 15, tau = (o >> 8) & 31, q = o >> 13; float s = 0.f;
        for (int p = 0; p < 64; ++p) { const float cr = a->C_re[(size_t)q * 1024 + h * 64 + p], ci = a->C_im[(size_t)q * 1024 + h * 64 + p];
            const float2 l = LP[(size_t)(q * 33 + tau) * 64 + p], b = BB[((size_t)q * 64 + p) * 16 + hp];
            const float xr = l.x * b.x - l.y * b.y, xi = l.x * b.y + l.y * b.x; s += cr * xr - ci * xi; }
        KT[o] = s;
    }
    for (int o = gt; o < 2 * 32 * 256 * 64; o += NGT) {
        const int half = o & 1, s = (o >> 1) & 31, n = (o >> 6) & 255, ig = o >> 14, i = ig >> 5, g = ig & 31;
        const int dir = n >> 7, part = (n >> 6) & 1, p = n & 63, q = (i * 2 + dir) * 32 + g, e = dir == 0 ? 31 - s : s;
        const float2 l = LP[(size_t)(q * 33 + e) * 64 + p]; float v[8];
#pragma unroll
        for (int j = 0; j < 8; ++j) { const float2 b = BB[((size_t)q * 64 + p) * 16 + half * 8 + j]; v[j] = part == 0 ? (l.x * b.x - l.y * b.y) : (l.x * b.y + l.y * b.x); }
        u32x4 w; w.x = cvt_pk_bf16(v[0], v[1]); w.y = cvt_pk_bf16(v[2], v[3]); w.z = cvt_pk_bf16(v[4], v[5]); w.w = cvt_pk_bf16(v[6], v[7]);
        *(u32x4*)((bf16_t*)(a->ws + WS_WST + (size_t)ig * SZ_WST) + (size_t)n * 512 + s * 16 + half * 8) = w;
    }
    for (int o = gt; o < 2 * 32 * 512 * 32; o += NGT) {
        const int cblk = o & 31, n = (o >> 5) & 511, ig = o >> 14, i = ig >> 5, g = ig & 31;
        const int kind = cblk >> 3, p0 = (cblk & 7) * 8, dir = kind >> 1, q = (i * 2 + dir) * 32 + g, t = n >> 4, h = n & 15, e = dir == 0 ? t + 1 : 32 - t; float v[8];
#pragma unroll
        for (int j = 0; j < 8; ++j) { const int p = p0 + j; const float cr = a->C_re[(size_t)q * 1024 + h * 64 + p], ci = a->C_im[(size_t)q * 1024 + h * 64 + p]; const float2 l = LP[(size_t)(q * 33 + e) * 64 + p];
            v[j] = (kind & 1) == 0 ? (cr * l.x - ci * l.y) : -(cr * l.y + ci * l.x); }
        u32x4 w; w.x = cvt_pk_bf16(v[0], v[1]); w.y = cvt_pk_bf16(v[2], v[3]); w.z = cvt_pk_bf16(v[4], v[5]); w.w = cvt_pk_bf16(v[6], v[7]);
        *(u32x4*)((bf16_t*)(a->ws + WS_MTOEP + (size_t)ig * SZ_MTOEP) + (size_t)n * 768 + 512 + cblk * 8) = w;
    }
}
__device__ __forceinline__ void wcat_fold(ArgsP a, int gt, int NGT) {
    for (int o = gt; o < 2 * 4 * 16 * 1024; o += NGT) {
        const int n = o & 1023, c8 = (o >> 10) & 15, g = (o >> 14) & 3, i = o >> 16; float acc[8];
#pragma unroll
        for (int j = 0; j < 8; ++j) acc[j] = 0.f;
        const float* pw = a->pool_w + ((size_t)(i * 4 + g) * 128 + c8 * 8) * 128; const float* sc = a->pool_scale + i * 512 + g * 128; const float* wo = a->ab_w_out + (size_t)i * DM * DM + (size_t)(g * 128) * DM + n;
        for (int d = 0; d < 128; ++d) { const float x = sc[d] * wo[(size_t)d * DM];
#pragma unroll
            for (int j = 0; j < 8; ++j) acc[j] += pw[j * 128 + d] * x; }
        u32x4 w; w.x = cvt_pk_bf16(acc[0], acc[1]); w.y = cvt_pk_bf16(acc[2], acc[3]); w.z = cvt_pk_bf16(acc[4], acc[5]); w.w = cvt_pk_bf16(acc[6], acc[7]);
        *(u32x4*)((bf16_t*)(a->ws + WS_WCAT) + (size_t)i * DM * DM + (size_t)n * DM + g * 128 + c8 * 8) = w;
    }
}
__device__ __forceinline__ void ssm_tables2(ArgsP a, int gt, int NGT) {
    const float* KT = (const float*)(a->ws + WS_KTAB);
    for (int o = gt; o < 2 * 32 * 512 * 64; o += NGT) {
        const int half = o & 1, s = (o >> 1) & 31, n = (o >> 6) & 511, ig = o >> 15, i = ig >> 5, g = ig & 31, t = n >> 4, h = n & 15;
        const int qf = (i * 2) * 32 + g, qb = (i * 2 + 1) * 32 + g; float v[8];
#pragma unroll
        for (int j = 0; j < 8; ++j) v[j] = 0.f;
        if (s <= t) { const float* k = KT + ((size_t)(qf * 32 + (t - s)) * 16 + h) * 16 + half * 8;
#pragma unroll
            for (int j = 0; j < 8; ++j) v[j] += k[j]; }
        if (s >= t) { const float* k = KT + ((size_t)(qb * 32 + (s - t)) * 16 + h) * 16 + half * 8;
#pragma unroll
            for (int j = 0; j < 8; ++j) v[j] += k[j]; }
        if (s == t) { const float dsk = a->ssm_D[i * 512 + g * 16 + h];
#pragma unroll
            for (int j = 0; j < 8; ++j) if (half * 8 + j == h) v[j] += dsk; }
        u32x4 w; w.x = cvt_pk_bf16(v[0], v[1]); w.y = cvt_pk_bf16(v[2], v[3]); w.z = cvt_pk_bf16(v[4], v[5]); w.w = cvt_pk_bf16(v[6], v[7]);
        *(u32x4*)((bf16_t*)(a->ws + WS_MTOEP + (size_t)ig * SZ_MTOEP) + (size_t)n * 768 + s * 16 + half * 8) = w;
    }
}

__device__ __forceinline__ void attn_table(ArgsP a, int gt, int NGT) {
    float* TB = (float*)(a->ws + WS_ATB);
    for (int o = gt; o < 2 * 8 * 16 * 4 * 16 * 64; o += NGT) {
        const int lane = o & 63, it = (o >> 6) & 15, qt = (o >> 10) & 3, h = (o >> 12) & 15, v = (o >> 16) & 7, i = o >> 19;
        const int ii = it >> 1, t = it & 1, fr = lane & 15, fq = lane >> 4, kc0 = qt == 0 ? 0 : (qt == 1 ? 8 : (qt == 2 ? 24 : 32));
        const int c = 16 * qt + fr, cs = min(max(c - 8, 0), 48); f32x4 w;
#pragma unroll
        for (int e = 0; e < 4; ++e) { const int kc = kc0 + 16 * t + 4 * fq + e; const bool valid = (kc >= cs) && (kc < cs + 16);
            w[e] = valid ? a->rpb[((size_t)(i * 16 + h) * 15 + (ii - v + 7)) * 31 + (kc - c + 15)] * 1.4426950408889634f : -1e30f; }
        *(f32x4*)(TB + (size_t)o * 4) = w;
    }
}

__device__ __forceinline__ void pool_phase(const bf16_t* ZP, bf16_t* CAT, int gw, int NGW, int lane) {
    const int gi = lane >> 4, w = 2 << gi, lo = w >> 1, hi = w - 1 - lo;
    for (int row = gw; row < MTOK; row += NGW) {
        const int tl = row & (SEQL - 1); float acc[8];
#pragma unroll
        for (int j = 0; j < 8; ++j) acc[j] = 0.f;
        const int d0 = -min(lo, tl), d1 = min(hi, SEQL - 1 - tl);
#pragma unroll
        for (int d = -8; d <= 7; ++d) if (d >= d0 && d <= d1) { const u32x4 z = *(const u32x4*)(ZP + (size_t)(row + d) * 512 + lane * 8);
            acc[0] += bf_lo(z.x); acc[1] += bf_hi(z.x); acc[2] += bf_lo(z.y); acc[3] += bf_hi(z.y); acc[4] += bf_lo(z.z); acc[5] += bf_hi(z.z); acc[6] += bf_lo(z.w); acc[7] += bf_hi(z.w); }
        const float inv = 1.0f / (float)(d1 - d0 + 1); const u32x4 z = *(const u32x4*)(ZP + (size_t)row * 512 + lane * 8);
        u32x4 o; o.x = cvt_pk_bf16(acc[0] * inv - bf_lo(z.x), acc[1] * inv - bf_hi(z.x)); o.y = cvt_pk_bf16(acc[2] * inv - bf_lo(z.y), acc[3] * inv - bf_hi(z.y));
        o.z = cvt_pk_bf16(acc[4] * inv - bf_lo(z.z), acc[5] * inv - bf_hi(z.z)); o.w = cvt_pk_bf16(acc[6] * inv - bf_lo(z.w), acc[7] * inv - bf_hi(z.w));
        *(u32x4*)(CAT + (size_t)row * 1024 + lane * 8) = o;
    }
}

__device__ __forceinline__ void carry_phase(ArgsP a, int i, int wave, int lane, int G) {
    const float* __restrict__ SL = (const float*)(a->ws + WS_SLOC); bf16_t* __restrict__ ZS = (bf16_t*)(a->ws + WS_ZS); const float2* LP = (const float2*)(a->ws + WS_LAMPOW);
    for (int item = wave * G + (int)blockIdx.x; item < 512; item += NWAV * G) {
        const int dir = item & 1, b = (item >> 1) & 7, g = item >> 4, q = (i * 2 + dir) * 32 + g, p = lane;
        const float2 lt = LP[(size_t)(q * 33 + 32) * 64 + p]; float cr = 0.f, ci = 0.f;
        const size_t rbase = (size_t)g * NCHUNK + b * 256;
        for (int c0 = 0; c0 < 256; c0 += 16) {
            float sr[16], si[16];
#pragma unroll
            for (int k = 0; k < 16; ++k) { const int c = dir == 0 ? c0 + k : 255 - (c0 + k); const size_t row = rbase + c; sr[k] = SL[row * 256 + dir * 128 + p]; si[k] = SL[row * 256 + dir * 128 + 64 + p]; }
#pragma unroll
            for (int k = 0; k < 16; ++k) { const int c = dir == 0 ? c0 + k : 255 - (c0 + k); const size_t row = rbase + c;
                bf16_t* z = ZS + row * 768 + 512 + dir * 128 + p;
                z[0] = (bf16_t)(cvt_pk_bf16(cr, cr) & 0xffffu); z[64] = (bf16_t)(cvt_pk_bf16(ci, ci) & 0xffffu);
                const float nr = lt.x * cr - lt.y * ci + sr[k], ni = lt.x * ci + lt.y * cr + si[k]; cr = nr; ci = ni; }
        }
    }
}

__device__ __forceinline__ void attn_phase(LAS unsigned char* lds, const bf16_t* QKV, const float* TBL  , bf16_t* O, int tid, int wave, int lane, int G) {
    LAS unsigned char* vt = lds + wave * 9216;
    const unsigned vt_addr = (unsigned)(uintptr_t)vt;
    const int fr = lane & 15, fq = lane >> 4;
    for (int it = (int)blockIdx.x * NWAV + wave; it < 65536; it += G * NWAV) {
        const int qt = it & 3, h = (it >> 2) & 15, r = (it >> 6) & 127, b = it >> 13;
        const int r0 = min(max(r - 4, 0), 120), kc0 = qt == 0 ? 0 : (qt == 1 ? 8 : (qt == 2 ? 24 : 32));
        const int c = 16 * qt + fr;
        const size_t tokq = (size_t)b * SEQL + r * 64 + c;
        const float* tb = TBL + ((size_t)(((r - r0) * 16 + h) * 4 + qt) * 16) * 256 + lane * 4;
        bf16x8 qf[2];
        const bf16_t* qh = QKV + ((size_t)(b * 16 + h) * SEQL) * 64; const bf16_t* kh = qh + (size_t)MTOK * DM; const bf16_t* vh = kh + (size_t)MTOK * DM;
        {
            const bf16_t* qsrc = qh + (size_t)(r * 64 + 16 * qt + (lane >> 3)) * 64 + (lane & 7) * 8;
            const u32x4 q0 = *(const u32x4*)qsrc, q1 = *(const u32x4*)(qsrc + (size_t)8 * 64);
            *(LAS u32x4*)(vt + (lane >> 3) * 144 + (lane & 7) * 16) = q0; *(LAS u32x4*)(vt + ((lane >> 3) + 8) * 144 + (lane & 7) * 16) = q1;
            qf[0] = *(const LAS bf16x8*)(vt + fr * 144 + 16 * fq); qf[1] = *(const LAS bf16x8*)(vt + fr * 144 + 64 + 16 * fq);
            asm volatile("s_waitcnt lgkmcnt(0)" ::: "memory"); }
        const int vkey = lane >> 3, vch = lane & 7;
        const bf16_t* vsrc = vh + (size_t)(r0 * 64 + kc0 + vkey) * 64 + vch * 8;
        u32x4 vr[4][2][4];
        f32x4 s[8][2]; u32x4 kr[4][2][4];
        const bf16_t* ksrc = kh + (size_t)(r0 * 64 + kc0 + vkey) * 64 + vch * 8;
#pragma unroll
        for (int i = 0; i < 8; ++i) { const bf16_t* src = ksrc + (size_t)i * 64 * 64;
#pragma unroll
            for (int j = 0; j < 4; ++j) kr[i >> 1][i & 1][j] = *(const u32x4*)(src + (size_t)j * 8 * 64); }
#pragma unroll
        for (int i = 0; i < 8; ++i)
#pragma unroll
            for (int t = 0; t < 2; ++t) s[i][t] = i < 4 ? *(const f32x4*)(tb + (i * 2 + t) * 256) : (f32x4){0.f, 0.f, 0.f, 0.f};
        __builtin_amdgcn_sched_barrier(0);
        f32x4 tb2[4][2];
#pragma unroll
        for (int ip = 0; ip < 4; ++ip) {
#pragma unroll
            for (int rr = 0; rr < 2; ++rr) { LAS unsigned char* dst = vt + rr * 4608 + vkey * 144 + vch * 16;
#pragma unroll
                for (int j = 0; j < 4; ++j) *(LAS u32x4*)(dst + j * 8 * 144) = kr[ip][rr][j]; }
            if (ip == 1) {
#pragma unroll
                for (int i = 0; i < 4; ++i)
#pragma unroll
                    for (int t = 0; t < 2; ++t) tb2[i][t] = *(const f32x4*)(tb + ((i + 4) * 2 + t) * 256); }
#pragma unroll
            for (int rr = 0; rr < 2; ++rr)
#pragma unroll
                for (int t = 0; t < 2; ++t) { const LAS unsigned char* kp = vt + rr * 4608 + (16 * t + fr) * 144 + 16 * fq;
                    const bf16x8 k0 = *(const LAS bf16x8*)kp, k1 = *(const LAS bf16x8*)(kp + 64);
                    s[2 * ip + rr][t] = __builtin_amdgcn_mfma_f32_16x16x32_bf16(k0, qf[0], s[2 * ip + rr][t], 0, 0, 0); s[2 * ip + rr][t] = __builtin_amdgcn_mfma_f32_16x16x32_bf16(k1, qf[1], s[2 * ip + rr][t], 0, 0, 0); }
            asm volatile("s_waitcnt lgkmcnt(0)" ::: "memory");
        }
#pragma unroll
        for (int i = 0; i < 4; ++i)
#pragma unroll
            for (int t = 0; t < 2; ++t) s[i + 4][t] = s[i + 4][t] + tb2[i][t];
        __builtin_amdgcn_sched_barrier(0);
#pragma unroll
        for (int i = 0; i < 8; ++i) { const bf16_t* src = vsrc + (size_t)i * 64 * 64;
#pragma unroll
            for (int j = 0; j < 4; ++j) vr[i >> 1][i & 1][j] = *(const u32x4*)(src + (size_t)j * 8 * 64); }
        __builtin_amdgcn_sched_barrier(0);
        float mx = -1e30f;
#pragma unroll
        for (int i = 0; i < 8; ++i)
#pragma unroll
            for (int t = 0; t < 2; ++t) mx = fmaxf(fmaxf(mx, fmaxf(s[i][t][0], s[i][t][1])), fmaxf(s[i][t][2], s[i][t][3]));
        mx = fmaxf(mx, __shfl_xor(mx, 16)); mx = fmaxf(mx, __shfl_xor(mx, 32));
        float sum = 0.f;
#pragma unroll
        for (int i = 0; i < 8; ++i)
#pragma unroll
            for (int t = 0; t < 2; ++t)
#pragma unroll
                for (int e = 0; e < 4; ++e) { const float pe = __builtin_amdgcn_exp2f(s[i][t][e] - mx); s[i][t][e] = pe; sum += pe; }
        sum += __shfl_xor(sum, 16); sum += __shfl_xor(sum, 32);
        f32x4 o[4];
#pragma unroll
        for (int dt = 0; dt < 4; ++dt) o[dt] = (f32x4){0.f, 0.f, 0.f, 0.f};
        const unsigned ad = vt_addr + (unsigned)((4 * fq + (fr >> 2)) * 144 + 8 * (fr & 3));
#pragma unroll
        for (int ip = 0; ip < 4; ++ip) {
#pragma unroll
            for (int rr = 0; rr < 2; ++rr) { LAS unsigned char* dst = vt + rr * 4608 + vkey * 144 + vch * 16;
#pragma unroll
                for (int j = 0; j < 4; ++j) *(LAS u32x4*)(dst + j * 8 * 144) = vr[ip][rr][j]; }
            union { u32x4 w; bf16x8 v; } pf0, pf1; pf0.w = pack8(s[2 * ip][0], s[2 * ip][1]); pf1.w = pack8(s[2 * ip + 1][0], s[2 * ip + 1][1]);
            s16x4 ta0, ta1, ta2, ta3, tb0, tb1, tb2, tb3, ua0, ua1, ua2, ua3, ub0, ub1, ub2, ub3;
            asm volatile("ds_read_b64_tr_b16 %0, %16\n\tds_read_b64_tr_b16 %1, %16 offset:32\n\tds_read_b64_tr_b16 %2, %16 offset:64\n\tds_read_b64_tr_b16 %3, %16 offset:96\n\t"
                         "ds_read_b64_tr_b16 %4, %16 offset:2304\n\tds_read_b64_tr_b16 %5, %16 offset:2336\n\tds_read_b64_tr_b16 %6, %16 offset:2368\n\tds_read_b64_tr_b16 %7, %16 offset:2400\n\t"
                         "ds_read_b64_tr_b16 %8, %16 offset:4608\n\tds_read_b64_tr_b16 %9, %16 offset:4640\n\tds_read_b64_tr_b16 %10, %16 offset:4672\n\tds_read_b64_tr_b16 %11, %16 offset:4704\n\t"
                         "ds_read_b64_tr_b16 %12, %16 offset:6912\n\tds_read_b64_tr_b16 %13, %16 offset:6944\n\tds_read_b64_tr_b16 %14, %16 offset:6976\n\tds_read_b64_tr_b16 %15, %16 offset:7008\n\ts_waitcnt lgkmcnt(0)"
                         : "=&v"(ta0), "=&v"(ta1), "=&v"(ta2), "=&v"(ta3), "=&v"(tb0), "=&v"(tb1), "=&v"(tb2), "=&v"(tb3), "=&v"(ua0), "=&v"(ua1), "=&v"(ua2), "=&v"(ua3), "=&v"(ub0), "=&v"(ub1), "=&v"(ub2), "=&v"(ub3) : "v"(ad) : "memory");
            bf16x8 vf;
            vf = (bf16x8){ta0[0], ta0[1], ta0[2], ta0[3], tb0[0], tb0[1], tb0[2], tb0[3]}; o[0] = __builtin_amdgcn_mfma_f32_16x16x32_bf16(vf, pf0.v, o[0], 0, 0, 0);
            vf = (bf16x8){ta1[0], ta1[1], ta1[2], ta1[3], tb1[0], tb1[1], tb1[2], tb1[3]}; o[1] = __builtin_amdgcn_mfma_f32_16x16x32_bf16(vf, pf0.v, o[1], 0, 0, 0);
            vf = (bf16x8){ta2[0], ta2[1], ta2[2], ta2[3], tb2[0], tb2[1], tb2[2], tb2[3]}; o[2] = __builtin_amdgcn_mfma_f32_16x16x32_bf16(vf, pf0.v, o[2], 0, 0, 0);
            vf = (bf16x8){ta3[0], ta3[1], ta3[2], ta3[3], tb3[0], tb3[1], tb3[2], tb3[3]}; o[3] = __builtin_amdgcn_mfma_f32_16x16x32_bf16(vf, pf0.v, o[3], 0, 0, 0);
            vf = (bf16x8){ua0[0], ua0[1], ua0[2], ua0[3], ub0[0], ub0[1], ub0[2], ub0[3]}; o[0] = __builtin_amdgcn_mfma_f32_16x16x32_bf16(vf, pf1.v, o[0], 0, 0, 0);
            vf = (bf16x8){ua1[0], ua1[1], ua1[2], ua1[3], ub1[0], ub1[1], ub1[2], ub1[3]}; o[1] = __builtin_amdgcn_mfma_f32_16x16x32_bf16(vf, pf1.v, o[1], 0, 0, 0);
            vf = (bf16x8){ua2[0], ua2[1], ua2[2], ua2[3], ub2[0], ub2[1], ub2[2], ub2[3]}; o[2] = __builtin_amdgcn_mfma_f32_16x16x32_bf16(vf, pf1.v, o[2], 0, 0, 0);
            vf = (bf16x8){ua3[0], ua3[1], ua3[2], ua3[3], ub3[0], ub3[1], ub3[2], ub3[3]}; o[3] = __builtin_amdgcn_mfma_f32_16x16x32_bf16(vf, pf1.v, o[3], 0, 0, 0);
        }
        const float inv = 1.0f / sum;
#pragma unroll
        for (int dt = 0; dt < 4; ++dt) { u32x2 w; w.x = cvt_pk_bf16(o[dt][0] * inv, o[dt][1] * inv); w.y = cvt_pk_bf16(o[dt][2] * inv, o[dt][3] * inv);
            *(LAS u32x2*)(vt + fr * 144 + (16 * dt + 4 * fq) * 2) = w; }
        { const u32x4 o0 = *(const LAS u32x4*)(vt + (lane >> 3) * 144 + (lane & 7) * 16), o1 = *(const LAS u32x4*)(vt + ((lane >> 3) + 8) * 144 + (lane & 7) * 16);
          bf16_t* od = O + ((size_t)b * SEQL + r * 64 + 16 * qt + (lane >> 3)) * 1024 + h * 64 + (lane & 7) * 8;
          __builtin_nontemporal_store(o0, (u32x4*)od); __builtin_nontemporal_store(o1, (u32x4*)(od + (size_t)8 * 1024));
          asm volatile("s_waitcnt lgkmcnt(0)" ::: "memory"); }
    }
}
#ifndef EN_SETUP
#define EN_SETUP 1
#endif
#ifndef EN_EVEN
#define EN_EVEN 1
#endif
#ifndef EN_ODD
#define EN_ODD 1
#endif
#ifndef EN_ATT
#define EN_ATT 1
#endif
#ifndef DUP_ROW
#define DUP_ROW 1
#endif
#ifndef DUP_ATT
#define DUP_ATT 1
#endif
#ifndef DUP_PC
#define DUP_PC 1
#endif
#ifndef DUP_FFN
#define DUP_FFN 1
#endif
#ifndef DUP_MIX
#define DUP_MIX 1
#endif
#ifndef DUP_P0
#define DUP_P0 1
#endif
#define GEMM_SP2 true
#define GEMM_ALIGN true
__global__ void __launch_bounds__(NTHR, 2) fwd_megakernel(Args kargs) {
    extern __shared__ __attribute__((aligned(16))) unsigned char lds_raw[];
    LAS unsigned char* lds = (LAS unsigned char*)lds_raw;
    cg::grid_group grid = cg::this_grid();
    const int G = gridDim.x, bx = blockIdx.x, NGW = G * NWAV, NGT = G * NTHR;
    const int lo = kargs.ph_lo, hi = kargs.ph_hi; int ph = 0;
    volatile LAS unsigned* xst = (volatile LAS unsigned*)(lds + 131072 + 8128);
    if (threadIdx.x < 2) xst[threadIdx.x] = 0u;
    __syncthreads();
    const XcdBarrier xbar = xcd_barrier_post((unsigned*)(kargs.ws + WS_BAR), xst);
#define PH_BEGIN if (ph >= lo && ph < hi) { ArgsP a = args_ptr(); int tid = threadIdx.x; asm volatile("" : "+v"(tid)); const int lane = tid & 63, wave = __builtin_amdgcn_readfirstlane(tid >> 6), gw = bx * NWAV + wave, gt = bx * NTHR + tid; \
    unsigned char* ws = a->ws; bf16_t* HB = (bf16_t*)(ws + WS_XN); bf16_t* SCR = (bf16_t*)a->out; float* RS = (float*)(ws + WS_RS); bf16_t* FB = (bf16_t*)(ws + WS_F); bf16_t* BIG = (bf16_t*)(ws + WS_BIG); bf16_t* ZS = (bf16_t*)(ws + WS_ZS); float* SLOC = (float*)(ws + WS_SLOC); bf16_t* YG = (bf16_t*)(ws + WS_YG); \
    (void)lane; (void)wave; (void)gw; (void)gt; (void)HB; (void)SCR; (void)RS; (void)FB; (void)BIG; (void)ZS; (void)SLOC; (void)YG;
#ifndef DUP_SYNC
#define DUP_SYNC 1
#endif
#define PH_END } { const bool seam = (ph >= lo && ph + 1 < hi); ++ph; if (seam) for (int rs = 0; rs < DUP_SYNC; ++rs) { if (ph == 2) grid.sync(); else xcd_barrier(xbar); } }

    PH_BEGIN
        ssm_tables0(a, gt, NGT);
    PH_END
    PH_BEGIN
      for (int rep = 0; rep < DUP_P0; ++rep) {
#if EN_SETUP
        ssm_tables1(a, gt, NGT);
        attn_table(a, gt, NGT);
        wcat_fold(a, gt, NGT);
        transposes_phase(a, (LAS float*)(lds + wave * 8448), gw, NGW, lane);
#endif
        rowwise_phase(a->x, HB, nullptr, nullptr, 0.f, RS, nullptr, gw, NGW, lane);
      }
    PH_END

#pragma nounroll
    for (int layer = 0; layer < 4; ++layer) {
        const int mi = layer >> 1;
#pragma nounroll
        for (int half = 0; half < 2; ++half) {
            if (half == 1) {
                if ((layer & 1) == 0) {
#if EN_EVEN
                    PH_BEGIN
                        pg8::Gemm g{HB, (const bf16_t*)(ws + WS_WIN) + (size_t)mi * DM * DM, MTOK, DM, DM, DM, DM, 0, 0}; pg8::StaticOrder S; S.init(MTOK, DM, G, bx);
                        LAS float* rsl = (LAS float*)(lds + 131072); rsl_fill(rsl, RS, bx, tid);
                        EpiZ E{FB, ZS, rsl};
                        for (int rep = 0; rep < DUP_MIX; ++rep) { pg8::gemm_phase<EpiZ, pg8::StaticOrder, GEMM_ALIGN, GEMM_SP2>(lds, g, S, E); }
                    PH_END
                    PH_BEGIN
                        for (int rep = 0; rep < DUP_PC; ++rep) pool_phase(FB, SCR, gw, NGW, lane);
                        pg8::Gemm g{ZS, (const bf16_t*)(ws + WS_WST + (size_t)mi * 32 * SZ_WST), NCHUNK, 256, 512, 768, 512, (size_t)NCHUNK * 768 * 2, SZ_WST}; BatchOrder S; S.init(NCHUNK, 256, 32, G, bx);
                        EpiState E{SLOC};
                        for (int rep = 0; rep < DUP_MIX; ++rep) { pg8::gemm_phase<EpiState, BatchOrder, GEMM_ALIGN, GEMM_SP2>(lds, g, S, E); }
                    PH_END
                    PH_BEGIN
                        for (int rep = 0; rep < DUP_PC; ++rep) { carry_phase(a, mi, wave, lane, G); }
                        if (layer == 0) ssm_tables2(a, gt, NGT);
                    PH_END
                    PH_BEGIN
                        pg8::Gemm g{ZS, (const bf16_t*)(ws + WS_MTOEP + (size_t)mi * 32 * SZ_MTOEP), NCHUNK, 512, 768, 768, 768, (size_t)NCHUNK * 768 * 2, SZ_MTOEP}; BatchOrder S; S.init(NCHUNK, 512, 32, G, bx);
                        EpiSsmOut E{YG};
                        for (int rep = 0; rep < DUP_MIX; ++rep) { pg8::gemm_phase<EpiSsmOut, BatchOrder, GEMM_ALIGN, GEMM_SP2>(lds, g, S, E); }
                    PH_END
                    PH_BEGIN
                        pg8::Gemm g{YG, (const bf16_t*)(ws + WS_WGLU) + (size_t)mi * 512 * 512, MTOK, 512, 512, 512, 512, 0, 0}; pg8::StaticOrder S; S.init(MTOK, 512, G, bx);
                        EpiGlu E{YG, a->b_glu + mi * 512, SCR};
                        for (int rep = 0; rep < DUP_MIX; ++rep) { pg8::gemm_phase<EpiGlu, pg8::StaticOrder, GEMM_ALIGN, GEMM_SP2>(lds, g, S, E); }
                    PH_END
                    PH_BEGIN
                        pg8::Gemm g{SCR, (const bf16_t*)(ws + WS_WCAT) + (size_t)mi * DM * DM, MTOK, DM, DM, DM, DM, 0, 0};
                        pg8::StaticOrder S; S.init(MTOK, DM, G, bx);
                        EpiResNorm E{HB, a->norm_g + (size_t)layer * 6 * DM + 3 * DM, 1.0f, (float*)(ws + WS_XS), RS, (unsigned*)(ws + WS_PCNT), 4u * (unsigned)(3 * layer + 2), nullptr, lds + 131072};
                        pg8::gemm_phase<EpiResNorm, pg8::StaticOrder, true, GEMM_SP2>(lds, g, S, E);
                    PH_END
#endif
                } else {
#if EN_ODD
                    PH_BEGIN
                        pg8::Gemm g{HB, (const bf16_t*)(ws + WS_WQKV) + (size_t)mi * 3072 * DM, MTOK, 3072, DM, DM, DM, 0, 0}; pg8::StaticOrder S; S.init(MTOK, 3072, G, bx);
                        LAS float* rsl = (LAS float*)(lds + 131072); rsl_fill(rsl, RS, bx, tid);
                        EpiQKV E{BIG, rsl};
                        for (int rep = 0; rep < DUP_MIX; ++rep) { pg8::gemm_phase<EpiQKV, pg8::StaticOrder, GEMM_ALIGN, GEMM_SP2>(lds, g, S, E); }
                    PH_END
                    PH_BEGIN
#if EN_ATT
                        for (int rep = 0; rep < DUP_ATT; ++rep) { attn_phase(lds, BIG, (const float*)(ws + WS_ATB) + (size_t)mi * 2097152, SCR, tid, wave, lane, G); }
#endif
                        __syncthreads();
                    PH_END
                    PH_BEGIN
                        pg8::Gemm g{SCR, (const bf16_t*)(ws + WS_WO) + (size_t)mi * DM * DM, MTOK, DM, DM, DM, DM, 0, 0};
                        pg8::StaticOrder S; S.init(MTOK, DM, G, bx);
                        EpiResNorm E{HB, a->norm_g + (size_t)layer * 6 * DM + 3 * DM, 1.0f, (float*)(ws + WS_XS), RS, (unsigned*)(ws + WS_PCNT), 4u * (unsigned)(3 * layer + 2), nullptr, lds + 131072};
                        pg8::gemm_phase<EpiResNorm, pg8::StaticOrder, true, GEMM_SP2>(lds, g, S, E);
                    PH_END
#endif
                }
            }
            const int f = layer * 2 + half;
            PH_BEGIN
                pg8::Gemm g{HB, (const bf16_t*)(ws + WS_WGU + (size_t)f * SZ_WGU), MTOK, 2 * DFF, DM, DM, DM, 0, 0}; pg8::StaticOrder S; S.init(MTOK, 2 * DFF, G, bx);
                LAS float* rsl = (LAS float*)(lds + 131072);
                { const int nwg = 256 * 22, q8 = nwg / 8, wg0 = (bx % 8) * q8 + bx / 8, off = (wg0 % 176) % 8;
#pragma unroll
                  for (int k = 0; k < 4; ++k) { const int pmk = 8 * ((bx % 8) * 4 + k) + off; if (tid < 256) rsl[k * 256 + tid] = row_rs(RS, pmk * 256 + tid); } }
                __syncthreads();
                EpiSwiglu E{BIG, rsl};
                for (int rep = 0; rep < DUP_FFN; ++rep) pg8::gemm_phase<EpiSwiglu, pg8::StaticOrder, GEMM_ALIGN, GEMM_SP2>(lds, g, S, E);
            PH_END
            PH_BEGIN
                pg8::Gemm g{BIG, (const bf16_t*)(ws + WS_WD + (size_t)f * SZ_WD), MTOK, DM, DFF, DFF, DFF, 0, 0};
                pg8::StaticOrder S; S.init(MTOK, DM, G, bx);
                EpiResNorm E{HB, a->norm_g + (size_t)layer * 6 * DM + (half == 0 ? 1 : 5) * DM, 0.5f, (float*)(ws + WS_XS), RS, (unsigned*)(ws + WS_PCNT), 4u * (unsigned)(3 * layer + (half == 0 ? 1 : 3)), (layer == 3 && half == 1) ? a->out : nullptr, lds + 131072};
                pg8::gemm_phase<EpiResNorm, pg8::StaticOrder, true, GEMM_SP2>(lds, g, S, E);
            PH_END
        }
    }
}

extern "C" void kernel_launch(void* const* d_in, const int* in_sizes, int n_in, void* d_out, int out_size, void* d_ws, size_t ws_size, hipStream_t stream) {
    static int grid = 0;
    if (grid == 0) {
        if (n_in != 22 || out_size != MTOK * DM || ws_size < WS_END) { fprintf(stderr, "kernel_launch: unexpected problem (n_in %d, out %d, ws %zu, need %zu)\n", n_in, out_size, ws_size, (size_t)WS_END); grid = -1; return; }
        int dev = 0, cus = 0, per_cu = 0;
        hipGetDevice(&dev); hipDeviceGetAttribute(&cus, hipDeviceAttributeMultiprocessorCount, dev);
        if (hipFuncSetAttribute((const void*)fwd_megakernel, hipFuncAttributeMaxDynamicSharedMemorySize, LDS_BYTES) != hipSuccess) { fprintf(stderr, "kernel_launch: hipFuncSetAttribute failed\n"); }
        if (hipOccupancyMaxActiveBlocksPerMultiprocessor(&per_cu, (const void*)fwd_megakernel, NTHR, LDS_BYTES) != hipSuccess || per_cu < 1) { fprintf(stderr, "kernel_launch: occupancy query says %d blocks/CU; using 1\n", per_cu); per_cu = 1; }
        (void)hipGetLastError();
        grid = cus * 1;
        if (per_cu < 1) grid = -1;
    }
    if (grid < 0) return;
    Args a{};
    a.x = (const float*)d_in[0]; a.norm_g = (const float*)d_in[1]; a.w_gate = (const float*)d_in[2]; a.w_up = (const float*)d_in[3]; a.w_down = (const float*)d_in[4];
    a.ab_w_in = (const float*)d_in[5]; a.pool_w = (const float*)d_in[6]; a.pool_scale = (const float*)d_in[7]; a.A_re = (const float*)d_in[8]; a.A_im = (const float*)d_in[9];
    a.log_dt = (const float*)d_in[10]; a.B_re = (const float*)d_in[11]; a.B_im = (const float*)d_in[12]; a.C_re = (const float*)d_in[13]; a.C_im = (const float*)d_in[14];
    a.ssm_D = (const float*)d_in[15]; a.w_glu = (const float*)d_in[16]; a.b_glu = (const float*)d_in[17]; a.ab_w_out = (const float*)d_in[18]; a.w_qkv = (const float*)d_in[19];
    a.rpb = (const float*)d_in[20]; a.na_w_out = (const float*)d_in[21];
    a.out = (float*)d_out; a.ws = (unsigned char*)d_ws; a.ph_lo = 0; a.ph_hi = 1 << 20;
    if (hipMemsetAsync((unsigned char*)d_ws + WS_BAR, 0, BAR_BYTES, stream) != hipSuccess) { fprintf(stderr, "kernel_launch: memset of barrier words failed\n"); return; }
    void* args[] = {&a};
    hipError_t e = hipLaunchCooperativeKernel((const void*)fwd_megakernel, dim3(grid), dim3(NTHR), args, LDS_BYTES, stream);
    if (e != hipSuccess) fprintf(stderr, "kernel_launch: cooperative launch failed: %s (grid %d)\n", hipGetErrorString(e), grid);
}
```
